# Optimizing an MI355X kernel written in HIP

```python
import math
import jax
import jax.numpy as jnp
from jax import lax
import numpy as np

D_MODEL = 1024
BATCH = 8
SEQ = 4096
DEPTH = 1
DEC_BATCH = 2
DEC_SEQ = 16384
PAST_LEN = 128

ATTN_WIDTH = D_MODEL // 2
HYENA_WIDTH = D_MODEL - ATTN_WIDTH
HEAD_DIM = 64
N_HEADS = ATTN_WIDTH // HEAD_DIM
DILATED_PATTERNS = ((128, 1), (512, 4), (2048, 16))
HYENA_ORDER = 2
SHORT_CONV_WIDTH = 3
FILTER_EMB_DIM = 33
FILTER_HIDDEN = 64
FILTER_FAST_DECAY_PCT = 0.3
FILTER_SLOW_DECAY_PCT = 1.5
FILTER_DECAY_TARGET = 1e-2
PROJ_WIDTH = 4 * ATTN_WIDTH + (HYENA_ORDER + 2) * HYENA_WIDTH
LN_EPS = 1e-5
RMS_EPS = 1e-6
NEG_INF = -1e30

kernel_name = 'hymba_hyena_dilated_alibi_deepnorm_encoder'


def _alibi_slopes(n):
    return jnp.asarray([2.0 ** (-8.0 * (i + 1) / n) for i in range(n)], jnp.float32)


def _dilated_window_attention(q, k, v, slopes, window, dilation):
    B, S, H, Dh = q.shape
    half = window // (2 * dilation)
    blk = half
    s_sub = S // dilation
    n_blk = -(-s_sub // blk)
    pad = n_blk * blk - s_sub
    N = B * dilation

    def to_sub(t):
        return t.reshape(B, s_sub, dilation, H, Dh).transpose(0, 2, 1, 3, 4).reshape(N, s_sub, H, Dh)

    qs, ks, vs = to_sub(q), to_sub(k), to_sub(v)
    qb = jnp.pad(qs, ((0, 0), (0, pad), (0, 0), (0, 0))).reshape(N, n_blk, blk, H, Dh)

    def neighbours(t):
        t = jnp.pad(t, ((0, 0), (blk, pad + blk), (0, 0), (0, 0))).reshape(N, n_blk + 2, blk, H, Dh)
        return jnp.concatenate([t[:, :-2], t[:, 1:-1], t[:, 2:]], axis=2)

    kb, vb = neighbours(ks), neighbours(vs)
    scores = jnp.einsum('nbqhd,nbkhd->nbhqk', qb, kb) * (Dh ** -0.5)
    q_idx = jnp.arange(n_blk)[:, None] * blk + jnp.arange(blk)[None, :]
    k_idx = jnp.arange(n_blk)[:, None] * blk - blk + jnp.arange(3 * blk)[None, :]
    rel = jnp.abs(k_idx[:, None, :] - q_idx[:, :, None])
    valid = (rel <= half) & (k_idx[:, None, :] >= 0) & (k_idx[:, None, :] < s_sub)
    dist = (rel * dilation).astype(jnp.float32)
    bias = -slopes[None, :, None, None] * dist[:, None]
    scores = jnp.where(valid[:, None], scores + bias, NEG_INF)
    m = jnp.max(scores, axis=-1, keepdims=True)
    p = jnp.exp(scores - m)
    l = jnp.sum(p, axis=-1, keepdims=True)
    o = jnp.einsum('nbhqk,nbkhd->nbqhd', p, vb) / jnp.swapaxes(l, 2, 3)
    lse = jnp.swapaxes((m + jnp.log(l))[..., 0], 2, 3)
    o = o.reshape(N, n_blk * blk, H, Dh)[:, :s_sub]
    o = o.reshape(B, dilation, s_sub, H, Dh).transpose(0, 2, 1, 3, 4).reshape(B, S, H, Dh)
    lse = lse.reshape(N, n_blk * blk, H)[:, :s_sub]
    lse = lse.reshape(B, dilation, s_sub, H).transpose(0, 2, 1, 3).reshape(B, S, H)
    return o, lse


def _hyena_filters(L, w1, b1, w2, b2, w3, b3, freq, w4):
    f32 = jnp.float32
    t = jnp.linspace(0.0, 1.0, L, dtype=f32)[:, None]
    bands = (FILTER_EMB_DIM - 1) // 2
    w = 2.0 * math.pi * jnp.arange(L, dtype=f32)[:, None] / L
    fr = jnp.linspace(1e-4, bands - 1, bands, dtype=f32)[None, :]
    z = jnp.concatenate([t, jnp.cos(fr * w), -jnp.sin(fr * w)], axis=-1)
    freq = freq.astype(f32)
    h = jnp.sin(freq[0] * (z @ w1.astype(f32) + b1.astype(f32)))
    h = jnp.sin(freq[1] * (h @ w2.astype(f32) + b2.astype(f32)))
    h = jnp.sin(freq[2] * (h @ w3.astype(f32) + b3.astype(f32)))
    h = (h @ w4.astype(f32)).reshape(L, HYENA_ORDER, 2, HYENA_WIDTH)
    max_decay = math.log(FILTER_DECAY_TARGET) / FILTER_FAST_DECAY_PCT
    min_decay = math.log(FILTER_DECAY_TARGET) / FILTER_SLOW_DECAY_PCT
    deltas = jnp.abs(jnp.linspace(min_decay, max_decay, HYENA_WIDTH, dtype=f32))
    decay = jnp.exp(-t * deltas[None, :])
    return h * decay[:, None, None, :]


def _two_sided_fftconv(u, h_fwd, h_bwd):
    L, C = h_fwd.shape
    filt = jnp.concatenate([h_fwd, jnp.zeros((1, C), h_fwd.dtype), h_bwd[1:][::-1]], axis=0)
    F = jnp.fft.rfft(filt, n=2 * L, axis=0)
    U = jnp.fft.rfft(u, n=2 * L, axis=1)
    return jnp.fft.irfft(U * F[None], n=2 * L, axis=1)[:, :L]


def _short_conv(u, w, b):
    r = SHORT_CONV_WIDTH // 2
    L = u.shape[1]
    up = jnp.pad(u, ((0, 0), (r, r), (0, 0)))
    out = b
    for j in range(SHORT_CONV_WIDTH):
        out = out + up[:, j:j + L] * w[j]
    return out


def _rms(y, g):
    y = y.astype(jnp.float32)
    return y * lax.rsqrt(jnp.mean(y * y, axis=-1, keepdims=True) + RMS_EPS) * g.astype(jnp.float32)


def _layer(x, w_in, conv_w, conv_b, filt_w1, filt_b1, filt_w2, filt_b2, filt_w3, filt_b3,
           filt_freq, filt_w4, hyena_d, attn_norm_g, hyena_norm_g, w_out, ln_g, ln_b):
    f32 = jnp.float32
    B, L, _ = x.shape
    A, C = ATTN_WIDTH, HYENA_WIDTH
    proj = x @ w_in
    q, k, v, g_attn = (proj[..., i * A:(i + 1) * A] for i in range(4))
    u_h = proj[..., 4 * A:4 * A + (HYENA_ORDER + 1) * C]
    g_hyena = proj[..., 4 * A + (HYENA_ORDER + 1) * C:]

    heads = lambda t: t.reshape(B, L, N_HEADS, HEAD_DIM).astype(f32)
    qh, kh, vh = heads(q), heads(k), heads(v)
    slopes = _alibi_slopes(N_HEADS)
    outs, lses = [], []
    for window, dilation in DILATED_PATTERNS:
        o, lse = _dilated_window_attention(qh, kh, vh, slopes, window, dilation)
        outs.append(o)
        lses.append(lse)
    wts = jax.nn.softmax(jnp.stack(lses), axis=0)
    attn = jnp.einsum('pblh,pblhd->blhd', wts, jnp.stack(outs)).reshape(B, L, A)

    u = _short_conv(u_h, conv_w, conv_b).astype(f32)
    z = u[..., :C]
    filters = _hyena_filters(L, filt_w1, filt_b1, filt_w2, filt_b2, filt_w3, filt_b3, filt_freq, filt_w4)
    for n in range(HYENA_ORDER):
        gate = u[..., (n + 1) * C:(n + 2) * C]
        z = gate * (_two_sided_fftconv(z, filters[:, n, 0], filters[:, n, 1]) + hyena_d[n].astype(f32) * z)

    mixed = jnp.concatenate([
        _rms(attn, attn_norm_g) * jax.nn.silu(g_attn.astype(f32)),
        _rms(z, hyena_norm_g) * jax.nn.silu(g_hyena.astype(f32)),
    ], axis=-1).astype(x.dtype)
    out = mixed @ w_out
    alpha = (2.0 * DEPTH) ** 0.25
    h = alpha * x.astype(f32) + out.astype(f32)
    mu = jnp.mean(h, axis=-1, keepdims=True)
    var = jnp.mean(jnp.square(h - mu), axis=-1, keepdims=True)
    y = (h - mu) * lax.rsqrt(var + LN_EPS) * ln_g.astype(f32) + ln_b.astype(f32)
    return y.astype(x.dtype)


def setup_inputs(seed: int = 0) -> dict:
    key = jax.random.key(seed)
    ks = jax.random.split(key, 24)
    f32 = jnp.float32
    nrm = lambda kk, shape, scale: jax.random.normal(kk, shape, f32) * scale
    beta = (8.0 * DEPTH) ** -0.25
    A, C = ATTN_WIDTH, HYENA_WIDTH
    col_scale = jnp.concatenate([
        jnp.ones((2 * A,), f32), jnp.full((A,), beta, f32), jnp.ones((A,), f32),
        jnp.full((C,), beta, f32), jnp.ones(((HYENA_ORDER + 1) * C,), f32)])
    return {
        'x_prompt': nrm(ks[0], (BATCH, SEQ, D_MODEL), 1.0),
        'x_sample': nrm(ks[1], (DEC_BATCH, DEC_SEQ, D_MODEL), 1.0),
        'w_in': nrm(ks[2], (DEPTH, D_MODEL, PROJ_WIDTH), D_MODEL ** -0.5) * col_scale,
        'conv_w': nrm(ks[3], (DEPTH, SHORT_CONV_WIDTH, (HYENA_ORDER + 1) * C), SHORT_CONV_WIDTH ** -0.5),
        'conv_b': nrm(ks[4], (DEPTH, (HYENA_ORDER + 1) * C), 0.01),
        'filt_w1': nrm(ks[5], (DEPTH, FILTER_EMB_DIM, FILTER_HIDDEN), FILTER_EMB_DIM ** -0.5),
        'filt_b1': nrm(ks[6], (DEPTH, FILTER_HIDDEN), 0.1),
        'filt_w2': nrm(ks[7], (DEPTH, FILTER_HIDDEN, FILTER_HIDDEN), FILTER_HIDDEN ** -0.5),
        'filt_b2': nrm(ks[8], (DEPTH, FILTER_HIDDEN), 0.1),
        'filt_w3': nrm(ks[9], (DEPTH, FILTER_HIDDEN, FILTER_HIDDEN), FILTER_HIDDEN ** -0.5),
        'filt_b3': nrm(ks[10], (DEPTH, FILTER_HIDDEN), 0.1),
        'filt_freq': 1.0 + nrm(ks[11], (DEPTH, 3, FILTER_HIDDEN), 0.01),
        'filt_w4': nrm(ks[12], (DEPTH, FILTER_HIDDEN, HYENA_ORDER * 2 * C), FILTER_HIDDEN ** -0.5),
        'hyena_d': nrm(ks[13], (DEPTH, HYENA_ORDER, C), 1.0),
        'attn_norm_g': 1.0 + nrm(ks[14], (DEPTH, A), 0.01),
        'hyena_norm_g': 1.0 + nrm(ks[15], (DEPTH, C), 0.01),
        'w_out': nrm(ks[16], (DEPTH, D_MODEL, D_MODEL), D_MODEL ** -0.5 * beta),
        'ln_g': 1.0 + nrm(ks[17], (DEPTH, D_MODEL), 0.01),
        'ln_b': nrm(ks[18], (DEPTH, D_MODEL), 0.01),
    }


def reference(x_prompt, x_sample, w_in, conv_w, conv_b, filt_w1, filt_b1, filt_w2, filt_b2,
              filt_w3, filt_b3, filt_freq, filt_w4, hyena_d, attn_norm_g, hyena_norm_g,
              w_out, ln_g, ln_b):
    def trunk(x):
        for l in range(DEPTH):
            x = _layer(x, w_in[l], conv_w[l], conv_b[l], filt_w1[l], filt_b1[l], filt_w2[l],
                       filt_b2[l], filt_w3[l], filt_b3[l], filt_freq[l], filt_w4[l], hyena_d[l],
                       attn_norm_g[l], hyena_norm_g[l], w_out[l], ln_g[l], ln_b[l])
        return x
    y_prompt = trunk(x_prompt)
    y_sample = trunk(x_sample)
    return (y_prompt, y_sample)
```

```cpp
#include <hip/hip_runtime.h>
#include <hip/hip_cooperative_groups.h>
#include <cstdio>
namespace cg = cooperative_groups;

typedef unsigned short u16;
typedef short bf16x8 __attribute__((ext_vector_type(8)));
typedef short s16x4 __attribute__((ext_vector_type(4)));
typedef float f32x16 __attribute__((ext_vector_type(16)));

#define NTOK 65536
#define MiB (1024L * 1024L)
#define OFF_QB (0 * MiB)
#define OFF_KB (64 * MiB)
#define OFF_VB (128 * MiB)
#define OFF_GB (192 * MiB)
#define OFF_UT (320 * MiB)
#define OFF_MIXED (64 * MiB)
#define OFF_WBOUT (384 * MiB)
#define OFF_Z2T (320 * MiB)
#define OFF_XB (0 * MiB)
#define OFF_Z1T (0 * MiB)
#define OFF_Z0T (64 * MiB)
#define LG_S 32832
#define LG_P 8256
#define OFF_GRS (128 * MiB)
#define OFF_GRP (128 * MiB + 1024L * LG_S * 2)
#define OFF_WBIN (212 * MiB)

struct Params {
  const float *x0, *x1, *w_in, *conv_w, *conv_b, *fw1, *fb1, *fw2, *fb2, *fw3, *fb3, *ffreq, *fw4, *hyd, *gna, *gnh, *w_out, *lng, *lnb;
  float* out;
  char* ws;
};

__device__ __forceinline__ u16 f2bf(float f) {
  unsigned u = __float_as_uint(f);
  u += 0x7fffu + ((u >> 16) & 1u);
  return (u16)(u >> 16);
}
__device__ __forceinline__ float bf2f(u16 b) { return __uint_as_float(((unsigned)b) << 16); }
__device__ __forceinline__ unsigned pack2(float a, float b) { return (unsigned)f2bf(a) | ((unsigned)f2bf(b) << 16); }
__device__ __forceinline__ float bflo(unsigned u) { return __uint_as_float(u << 16); }
__device__ __forceinline__ float bfhi(unsigned u) { return __uint_as_float(u & 0xffff0000u); }
__device__ __forceinline__ float silu_f(float x) { return x / (1.f + __expf(-x)); }

__device__ __forceinline__ void tok_info(int tok, int& t, int& L, int& seqbase) {
  if (tok < 32768) { L = 4096; t = tok & 4095; seqbase = tok & ~4095; }
  else { L = 16384; t = tok & 16383; seqbase = tok & ~16383; }
}

__device__ void filter_item(const Params& p, int item, char* smem) {
  const int tid = threadIdx.x;
  const bool samp = item < 512;
  const int L = samp ? 16384 : 4096;
  const int LG = samp ? LG_S : LG_P;
  const int l0 = (samp ? item : item - 512) * 32;
  u16* GR = (u16*)((char*)p.out + (samp ? OFF_GRS : OFF_GRP));
  float* zs = (float*)smem;
  float* ha = zs + 32 * 36;
  float* hb = ha + 32 * 64;
  __syncthreads();
  for (int i = tid; i < 32 * 33; i += 512) {
    int l = i / 33, f = i - l * 33;
    int lag = l0 + l;
    float t = (float)lag / (float)(L - 1);
    float w = (float)lag / (float)L;
    float v;
    if (f == 0) v = t;
    else {
      int j = (f - 1) & 15;
      float fr = 1e-4f + (float)j * ((15.0f - 1e-4f) / 15.0f);
      float a = fr * w;
      v = (f <= 16) ? __builtin_amdgcn_cosf(a) : -__builtin_amdgcn_sinf(a);
    }
    zs[l * 36 + f] = v;
  }
  __syncthreads();
#pragma unroll 1
  for (int q = 0; q < 4; ++q) {
    int o = tid + 512 * q; int l = o >> 6, u = o & 63;
    float acc = p.fb1[u];
#pragma unroll 3
    for (int f = 0; f < 33; ++f) acc += zs[l * 36 + f] * p.fw1[f * 64 + u];
    ha[l * 64 + u] = __sinf(p.ffreq[u] * acc);
  }
  __syncthreads();
#pragma unroll 1
  for (int q = 0; q < 4; ++q) {
    int o = tid + 512 * q; int l = o >> 6, u = o & 63;
    float acc = p.fb2[u];
#pragma unroll 4
    for (int f = 0; f < 64; ++f) acc += ha[l * 64 + f] * p.fw2[f * 64 + u];
    hb[l * 64 + u] = __sinf(p.ffreq[64 + u] * acc);
  }
  __syncthreads();
#pragma unroll 1
  for (int q = 0; q < 4; ++q) {
    int o = tid + 512 * q; int l = o >> 6, u = o & 63;
    float acc = p.fb3[u];
#pragma unroll 4
    for (int f = 0; f < 64; ++f) acc += hb[l * 64 + f] * p.fw3[f * 64 + u];
    ha[l * 64 + u] = __sinf(p.ffreq[128 + u] * acc);
  }
  __syncthreads();
  const int c = tid;
  const float min_decay = -3.0701134573253943f;
  const float max_decay = -15.350567286626972f;
  const float delta = fabsf(min_decay + (max_decay - min_decay) * ((float)c / 511.0f));
#pragma unroll 1
  for (int lh = 0; lh < 4; ++lh) {
    float acc[8][4];
#pragma unroll
    for (int l = 0; l < 8; ++l)
#pragma unroll
      for (int q = 0; q < 4; ++q) acc[l][q] = 0.f;
#pragma unroll 2
    for (int j = 0; j < 64; ++j) {
      float wv[4];
#pragma unroll
      for (int q = 0; q < 4; ++q) wv[q] = p.fw4[j * 2048 + q * 512 + c];
#pragma unroll
      for (int l = 0; l < 8; ++l) {
        float hv = ha[(lh * 8 + l) * 64 + j];
#pragma unroll
        for (int q = 0; q < 4; ++q) acc[l][q] += hv * wv[q];
      }
    }
#pragma unroll
    for (int l = 0; l < 8; ++l) {
      int lag = l0 + lh * 8 + l;
      float t = (float)lag / (float)(L - 1);
      float dec = expf(-t * delta);
#pragma unroll
      for (int q = 0; q < 4; ++q) {
        int n = q >> 1, dir = q & 1;
        long row = (long)(n * 512 + c) * LG;
        if (dir == 0) GR[row + (L + 32 - lag)] = f2bf(acc[l][q] * dec);
        else if (lag > 0) GR[row + (L + 32 + lag)] = f2bf(acc[l][q] * dec);
      }
    }
  }
  if (l0 == 0) {
    for (int rr = 0; rr < 2; ++rr) {
      long row = (long)(tid + 512 * rr) * LG;
      for (int i = 0; i <= 32; ++i) GR[row + i] = 0;
      for (int i = 0; i < 32; ++i) GR[row + 2 * L + 32 + i] = 0;
    }
  }
}

__device__ void phase0(const Params& p, char* smem) {
  const int tid = threadIdx.x, bid = blockIdx.x, nb = gridDim.x;
  u16* xb = (u16*)((char*)p.out + OFF_XB);
  const long nchunk = (long)NTOK * 1024 / 8;
  for (long cidx = (long)bid * 512 + tid; cidx < nchunk; cidx += (long)nb * 512) {
    long e = cidx * 8;
    const float* src = (e < 32768L * 1024) ? (p.x0 + e) : (p.x1 + (e - 32768L * 1024));
    float4 a = *(const float4*)src, b = *(const float4*)(src + 4);
    uint4 o;
    o.x = pack2(a.x, a.y); o.y = pack2(a.z, a.w); o.z = pack2(b.x, b.y); o.w = pack2(b.z, b.w);
    *(uint4*)(xb + e) = o;
  }
  u16* wbin = (u16*)((char*)p.out + OFF_WBIN);
  for (int id = bid * 512 + tid; id < 4096 * 128; id += nb * 512) {
    int n = id & 4095, kc = id >> 12;
    float v[8];
#pragma unroll
    for (int j = 0; j < 8; ++j) v[j] = p.w_in[(long)(kc * 8 + j) * 4096 + n];
    uint4 o;
    o.x = pack2(v[0], v[1]); o.y = pack2(v[2], v[3]); o.z = pack2(v[4], v[5]); o.w = pack2(v[6], v[7]);
    *(uint4*)(wbin + (long)n * 1024 + kc * 8) = o;
  }
  for (int item = bid; item < 640; item += nb) filter_item(p, item, smem);
}

__device__ void convert_wout(const Params& p) {
  const int tid = threadIdx.x, bid = blockIdx.x, nb = gridDim.x;
  u16* wb = (u16*)(p.ws + OFF_WBOUT);
  for (int id = bid * 512 + tid; id < 1024 * 128; id += nb * 512) {
    int n = id & 1023, kc = id >> 10;
    float v[8];
#pragma unroll
    for (int j = 0; j < 8; ++j) v[j] = p.w_out[(long)(kc * 8 + j) * 1024 + n];
    uint4 o;
    o.x = pack2(v[0], v[1]); o.y = pack2(v[2], v[3]); o.z = pack2(v[4], v[5]); o.w = pack2(v[6], v[7]);
    *(uint4*)(wb + (long)n * 1024 + kc * 8) = o;
  }
}

#define QSCALE 0.18033688011112042f
#define LOG2E 1.4426950408889634f

__device__ __forceinline__ void inproj_store1(const Params& p, int tok, int col, float v) {
  u16* ws16 = (u16*)p.ws;
  if (col < 512) ws16[(OFF_QB >> 1) + (long)tok * 512 + col] = f2bf(v * QSCALE);
  else if (col < 1024) ws16[(OFF_KB >> 1) + (long)tok * 512 + (col - 512)] = f2bf(v);
  else if (col < 1536) ws16[(OFF_VB >> 1) + (long)tok * 512 + (col - 1024)] = f2bf(v);
  else if (col < 2048) ws16[(OFF_GB >> 1) + (long)tok * 1024 + (col - 1536)] = f2bf(silu_f(v));
  else if (col < 3584) ws16[(OFF_UT >> 1) + (long)(col - 2048) * NTOK + tok] = f2bf(v);
  else ws16[(OFF_GB >> 1) + (long)tok * 1024 + 512 + (col - 3584)] = f2bf(silu_f(v));
}

__device__ __forceinline__ float shortconv_at(const Params& p, int ch, int tok) {
  const u16* row = (const u16*)(p.ws + OFF_UT) + (long)ch * NTOK;
  int t, L, sb; tok_info(tok, t, L, sb);
  float a = (t > 0) ? bf2f(row[tok - 1]) : 0.f;
  float b = bf2f(row[tok]);
  float c = (t < L - 1) ? bf2f(row[tok + 1]) : 0.f;
  return p.conv_b[ch] + p.conv_w[ch] * a + p.conv_w[1536 + ch] * b + p.conv_w[3072 + ch] * c;
}

__global__ void __launch_bounds__(512) k_phase0(Params p) {
  extern __shared__ __attribute__((aligned(16))) char smem[];
  phase0(p, smem);
}
__global__ void __launch_bounds__(512) k_convert_wout(Params p) { convert_wout(p); }

__global__ void __launch_bounds__(256) n_inproj(Params p) {
  long gid = (long)blockIdx.x * 256 + threadIdx.x;
  int col = (int)(gid & 4095), tok = (int)(gid >> 12);
  const u16* xb = (const u16*)((char*)p.out + OFF_XB) + (long)tok * 1024;
  const u16* wb = (const u16*)((char*)p.out + OFF_WBIN) + (long)col * 1024;
  float acc = 0.f;
  for (int k = 0; k < 1024; k += 8) {
    uint4 a = *(const uint4*)(xb + k), b = *(const uint4*)(wb + k);
    acc += bflo(a.x) * bflo(b.x) + bfhi(a.x) * bfhi(b.x) + bflo(a.y) * bflo(b.y) + bfhi(a.y) * bfhi(b.y)
         + bflo(a.z) * bflo(b.z) + bfhi(a.z) * bfhi(b.z) + bflo(a.w) * bflo(b.w) + bfhi(a.w) * bfhi(b.w);
  }
  inproj_store1(p, tok, col, acc);
}

__global__ void __launch_bounds__(256) n_attn(Params p) {
  int gid = blockIdx.x * 256 + threadIdx.x;
  int tok = gid & 65535, head = gid >> 16;
  int t, L, sb; tok_info(tok, t, L, sb);
  u16* Qb = (u16*)(p.ws + OFF_QB);
  const u16* Kb = (const u16*)(p.ws + OFF_KB);
  const u16* Vb = (const u16*)(p.ws + OFF_VB);
  float q[64], o[64];
#pragma unroll
  for (int d = 0; d < 64; ++d) { q[d] = bf2f(Qb[(long)tok * 512 + head * 64 + d]); o[d] = 0.f; }
  float m = -1e30f, l = 0.f;
  const float slope2 = exp2f(-(float)(head + 1)) * LOG2E;
  for (int pat = 0; pat < 3; ++pat) {
    int dil = (pat == 0) ? 1 : (pat == 1 ? 4 : 16);
    for (int j = -64; j <= 64; ++j) {
      int tk = t + j * dil;
      if (tk < 0 || tk >= L) continue;
      const u16* kr = Kb + (long)(sb + tk) * 512 + head * 64;
      const u16* vr = Vb + (long)(sb + tk) * 512 + head * 64;
      float s = 0.f;
#pragma unroll
      for (int d = 0; d < 64; ++d) s += q[d] * bf2f(kr[d]);
      s -= slope2 * (float)(abs(j) * dil);
      if (s > m) {
        float sc = exp2f(m - s);
        l *= sc;
#pragma unroll
        for (int d = 0; d < 64; ++d) o[d] *= sc;
        m = s;
      }
      float pr = exp2f(s - m);
      l += pr;
#pragma unroll
      for (int d = 0; d < 64; ++d) o[d] += pr * bf2f(vr[d]);
    }
  }
  float inv = 1.f / l;
#pragma unroll
  for (int d = 0; d < 64; ++d) Qb[(long)tok * 512 + head * 64 + d] = f2bf(o[d] * inv);
}

__global__ void __launch_bounds__(256) n_z0(Params p) {
  int gid = blockIdx.x * 256 + threadIdx.x;
  int tok = gid & 65535, c = gid >> 16;
  u16* z0 = (u16*)((char*)p.out + OFF_Z0T);
  z0[(long)c * NTOK + tok] = f2bf(shortconv_at(p, c, tok));
}

__global__ void __launch_bounds__(256) n_conv(Params p, int order) {
  int gid = blockIdx.x * 256 + threadIdx.x;
  int tok = gid & 65535, c = gid >> 16;
  int t, L, sb; tok_info(tok, t, L, sb);
  const bool samp = tok >= 32768;
  const u16* src = (order == 0) ? (const u16*)((char*)p.out + OFF_Z0T) : (const u16*)((char*)p.out + OFF_Z1T);
  const u16* urow = src + (long)c * NTOK + sb;
  const u16* gr = (const u16*)((char*)p.out + (samp ? OFF_GRS : OFF_GRP)) + (long)(order * 512 + c) * (samp ? LG_S : LG_P);
  const u16* g0 = gr + (L + 32 - t);
  float y = 0.f;
  for (int s = 0; s < L; ++s) y += bf2f(g0[s]) * bf2f(urow[s]);
  float gate = shortconv_at(p, 512 * (order + 1) + c, tok);
  float dv = p.hyd[order * 512 + c];
  float r = gate * (y + dv * bf2f(urow[t]));
  u16* dst = (order == 0) ? (u16*)((char*)p.out + OFF_Z1T) : (u16*)(p.ws + OFF_Z2T);
  dst[(long)c * NTOK + tok] = f2bf(r);
}

__global__ void __launch_bounds__(256) n_outproj(Params p) {
  long gid = (long)blockIdx.x * 256 + threadIdx.x;
  int col = (int)(gid & 1023), tok = (int)(gid >> 10);
  const u16* a = (const u16*)(p.ws + OFF_MIXED) + (long)tok * 1024;
  const u16* wb = (const u16*)(p.ws + OFF_WBOUT) + (long)col * 1024;
  float acc = 0.f;
  for (int k = 0; k < 1024; k += 8) {
    uint4 x = *(const uint4*)(a + k), b = *(const uint4*)(wb + k);
    acc += bflo(x.x) * bflo(b.x) + bfhi(x.x) * bfhi(b.x) + bflo(x.y) * bflo(b.y) + bfhi(x.y) * bfhi(b.y)
         + bflo(x.z) * bflo(b.z) + bfhi(x.z) * bfhi(b.z) + bflo(x.w) * bflo(b.w) + bfhi(x.w) * bfhi(b.w);
  }
  const float* xr = (tok < 32768) ? (p.x0 + (long)tok * 1024) : (p.x1 + (long)(tok - 32768) * 1024);
  p.out[(long)tok * 1024 + col] = 1.189207115002721f * xr[col] + acc;
}

__device__ __forceinline__ float wave_sum(float v) {
#pragma unroll
  for (int o = 32; o; o >>= 1) v += __shfl_xor(v, o);
  return v;
}

__device__ __forceinline__ void mixed_row(const Params& p, int tok, int lane) {
  u16* mixed = (u16*)(p.ws + OFF_MIXED) + (long)tok * 1024;
  const u16* Gb = (const u16*)(p.ws + OFF_GB) + (long)tok * 1024;
  {
    uint4 a = *(const uint4*)((const u16*)(p.ws + OFF_QB) + (long)tok * 512 + lane * 8);
    float v[8] = {bflo(a.x), bfhi(a.x), bflo(a.y), bfhi(a.y), bflo(a.z), bfhi(a.z), bflo(a.w), bfhi(a.w)};
    float ssq = 0.f;
#pragma unroll
    for (int j = 0; j < 8; ++j) ssq += v[j] * v[j];
    ssq = wave_sum(ssq);
    float r = rsqrtf(ssq * (1.f / 512.f) + 1e-6f);
    uint4 g = *(const uint4*)(Gb + lane * 8);
    float sg[8] = {bflo(g.x), bfhi(g.x), bflo(g.y), bfhi(g.y), bflo(g.z), bfhi(g.z), bflo(g.w), bfhi(g.w)};
    float4 n0 = *(const float4*)(p.gna + lane * 8), n1 = *(const float4*)(p.gna + lane * 8 + 4);
    float gn[8] = {n0.x, n0.y, n0.z, n0.w, n1.x, n1.y, n1.z, n1.w};
    float o[8];
#pragma unroll
    for (int j = 0; j < 8; ++j) o[j] = v[j] * r * gn[j] * sg[j];
    uint4 w; w.x = pack2(o[0], o[1]); w.y = pack2(o[2], o[3]); w.z = pack2(o[4], o[5]); w.w = pack2(o[6], o[7]);
    *(uint4*)(mixed + lane * 8) = w;
  }
  {
    const u16* z2 = (const u16*)(p.ws + OFF_Z2T);
    float v[8];
    float ssq = 0.f;
#pragma unroll
    for (int j = 0; j < 8; ++j) { v[j] = bf2f(z2[(long)(lane * 8 + j) * NTOK + tok]); ssq += v[j] * v[j]; }
    ssq = wave_sum(ssq);
    float r = rsqrtf(ssq * (1.f / 512.f) + 1e-6f);
    uint4 g = *(const uint4*)(Gb + 512 + lane * 8);
    float sg[8] = {bflo(g.x), bfhi(g.x), bflo(g.y), bfhi(g.y), bflo(g.z), bfhi(g.z), bflo(g.w), bfhi(g.w)};
    float4 n0 = *(const float4*)(p.gnh + lane * 8), n1 = *(const float4*)(p.gnh + lane * 8 + 4);
    float gn[8] = {n0.x, n0.y, n0.z, n0.w, n1.x, n1.y, n1.z, n1.w};
    float o[8];
#pragma unroll
    for (int j = 0; j < 8; ++j) o[j] = v[j] * r * gn[j] * sg[j];
    uint4 w; w.x = pack2(o[0], o[1]); w.y = pack2(o[2], o[3]); w.z = pack2(o[4], o[5]); w.w = pack2(o[6], o[7]);
    *(uint4*)(mixed + 512 + lane * 8) = w;
  }
}

__device__ __forceinline__ void ln_row(const Params& p, int tok, int lane) {
  float* row = p.out + (long)tok * 1024;
  float4 v[4];
  float s = 0.f;
#pragma unroll
  for (int q = 0; q < 4; ++q) { v[q] = *(const float4*)(row + q * 256 + lane * 4); s += v[q].x + v[q].y + v[q].z + v[q].w; }
  s = wave_sum(s);
  float mu = s * (1.f / 1024.f);
  float ss = 0.f;
#pragma unroll
  for (int q = 0; q < 4; ++q) {
    float a = v[q].x - mu, b = v[q].y - mu, c = v[q].z - mu, d = v[q].w - mu;
    ss += a * a + b * b + c * c + d * d;
  }
  ss = wave_sum(ss);
  float rstd = rsqrtf(ss * (1.f / 1024.f) + 1e-5f);
#pragma unroll
  for (int q = 0; q < 4; ++q) {
    float4 g = *(const float4*)(p.lng + q * 256 + lane * 4), b = *(const float4*)(p.lnb + q * 256 + lane * 4);
    float4 o;
    o.x = (v[q].x - mu) * rstd * g.x + b.x; o.y = (v[q].y - mu) * rstd * g.y + b.y;
    o.z = (v[q].z - mu) * rstd * g.z + b.z; o.w = (v[q].w - mu) * rstd * g.w + b.w;
    *(float4*)(row + q * 256 + lane * 4) = o;
  }
}

__global__ void __launch_bounds__(512) k_mixed(Params p) {
  int tok = blockIdx.x * 8 + (threadIdx.x >> 6);
  mixed_row(p, tok, threadIdx.x & 63);
}
__global__ void __launch_bounds__(512) k_ln(Params p) {
  int tok = blockIdx.x * 8 + (threadIdx.x >> 6);
  ln_row(p, tok, threadIdx.x & 63);
}

#define LDSROW 144
#define TILEB (256 * LDSROW)
#define GEMM_LDS (4 * TILEB)

template <class Epi>
__device__ __forceinline__ void gemm_tile(const u16* __restrict__ A, long lda, const u16* __restrict__ B, long ldb,
                                          int K, char* smem, Epi& epi) {
  const int tid = threadIdx.x, lane = tid & 63, w = tid >> 6, wm = w >> 2, wn = w & 3;
  const int l31 = lane & 31, h = lane >> 5;
  f32x16 acc[4][2];
#pragma unroll
  for (int mi = 0; mi < 4; ++mi)
#pragma unroll
    for (int ni = 0; ni < 2; ++ni)
#pragma unroll
      for (int j = 0; j < 16; ++j) acc[mi][ni][j] = 0.f;
  uint4 ra0, ra1, ra2, ra3, rb0, rb1, rb2, rb3;
  const int srow = tid >> 3, skc = tid & 7;
  const u16* Ag = A + (long)srow * lda + skc * 8;
  const u16* Bg = B + (long)srow * ldb + skc * 8;
  const int soff = srow * LDSROW + skc * 16;
  const int nk = K >> 6;
#define GLD(kk) do { \
    ra0 = *(const uint4*)(Ag + (kk)); ra1 = *(const uint4*)(Ag + 64 * lda + (kk)); ra2 = *(const uint4*)(Ag + 128 * lda + (kk)); ra3 = *(const uint4*)(Ag + 192 * lda + (kk)); \
    rb0 = *(const uint4*)(Bg + (kk)); rb1 = *(const uint4*)(Bg + 64 * ldb + (kk)); rb2 = *(const uint4*)(Bg + 128 * ldb + (kk)); rb3 = *(const uint4*)(Bg + 192 * ldb + (kk)); } while (0)
#define SST(d) do { \
    *(uint4*)((d) + soff) = ra0; *(uint4*)((d) + soff + 64 * LDSROW) = ra1; *(uint4*)((d) + soff + 128 * LDSROW) = ra2; *(uint4*)((d) + soff + 192 * LDSROW) = ra3; \
    *(uint4*)((d) + TILEB + soff) = rb0; *(uint4*)((d) + TILEB + soff + 64 * LDSROW) = rb1; *(uint4*)((d) + TILEB + soff + 128 * LDSROW) = rb2; *(uint4*)((d) + TILEB + soff + 192 * LDSROW) = rb3; } while (0)
  GLD(0);
  __syncthreads();
  SST(smem);
  __syncthreads();
  for (int kt = 0; kt < nk; ++kt) {
    if (kt + 1 < nk) GLD((kt + 1) * 64);
    const char* a = smem + (kt & 1) * 2 * TILEB;
    const char* b = a + TILEB;
#pragma unroll
    for (int ks = 0; ks < 4; ++ks) {
      bf16x8 af[4], bfr[2];
#pragma unroll
      for (int mi = 0; mi < 4; ++mi) af[mi] = *(const bf16x8*)(a + (wm * 128 + mi * 32 + l31) * LDSROW + ks * 32 + h * 16);
#pragma unroll
      for (int ni = 0; ni < 2; ++ni) bfr[ni] = *(const bf16x8*)(b + (wn * 64 + ni * 32 + l31) * LDSROW + ks * 32 + h * 16);
#pragma unroll
      for (int mi = 0; mi < 4; ++mi)
#pragma unroll
        for (int ni = 0; ni < 2; ++ni)
          acc[mi][ni] = __builtin_amdgcn_mfma_f32_32x32x16_bf16(af[mi], bfr[ni], acc[mi][ni], 0, 0, 0);
    }
    if (kt + 1 < nk) {
      char* d = smem + ((kt + 1) & 1) * 2 * TILEB;
      SST(d);
    }
    __syncthreads();
  }
#pragma unroll
  for (int mi = 0; mi < 4; ++mi)
#pragma unroll
    for (int ni = 0; ni < 2; ++ni)
#pragma unroll
      for (int g = 0; g < 4; ++g)
        epi(wm * 128 + mi * 32 + 8 * g + 4 * h, wn * 64 + ni * 32 + l31,
            acc[mi][ni][4 * g], acc[mi][ni][4 * g + 1], acc[mi][ni][4 * g + 2], acc[mi][ni][4 * g + 3]);
}

struct EpiTokMajor {
  char* ws; int nt; int tok0;
  __device__ __forceinline__ void operator()(int m, int n, float v0, float v1, float v2, float v3) const {
    int tok = tok0 + n;
    int col = nt * 256 + m;
    u16* dst;
    if (col < 512) { dst = (u16*)(ws + OFF_QB) + (long)tok * 512 + col; v0 *= QSCALE; v1 *= QSCALE; v2 *= QSCALE; v3 *= QSCALE; }
    else if (col < 1024) dst = (u16*)(ws + OFF_KB) + (long)tok * 512 + (col - 512);
    else if (col < 1536) dst = (u16*)(ws + OFF_VB) + (long)tok * 512 + (col - 1024);
    else {
      int gc = (col < 2048) ? (col - 1536) : (512 + col - 3584);
      dst = (u16*)(ws + OFF_GB) + (long)tok * 1024 + gc;
      v0 = silu_f(v0); v1 = silu_f(v1); v2 = silu_f(v2); v3 = silu_f(v3);
    }
    uint2 o; o.x = pack2(v0, v1); o.y = pack2(v2, v3);
    *(uint2*)dst = o;
  }
};
struct EpiChanMajor {
  char* ws; int ch0; int tok0;
  __device__ __forceinline__ void operator()(int m, int n, float v0, float v1, float v2, float v3) const {
    u16* dst = (u16*)(ws + OFF_UT) + (long)(ch0 + n) * NTOK + tok0 + m;
    uint2 o; o.x = pack2(v0, v1); o.y = pack2(v2, v3);
    *(uint2*)dst = o;
  }
};

__device__ void phase1(const Params& p, char* smem) {
  const u16* xb = (const u16*)((char*)p.out + OFF_XB);
  const u16* wb = (const u16*)((char*)p.out + OFF_WBIN);
  for (int mt = blockIdx.x; mt < 256; mt += gridDim.x) {
    const int tok0 = mt * 256;
    for (int nt = 0; nt < 16; ++nt) {
      if (nt >= 8 && nt < 14) {
        EpiChanMajor e{p.ws, (nt - 8) * 256, tok0};
        gemm_tile(xb + (long)tok0 * 1024, 1024, wb + (long)nt * 256 * 1024, 1024, 1024, smem, e);
      } else {
        EpiTokMajor e{p.ws, nt, tok0};
        gemm_tile(wb + (long)nt * 256 * 1024, 1024, xb + (long)tok0 * 1024, 1024, 1024, smem, e);
      }
    }
  }
}
__global__ void __launch_bounds__(512) k_phase1(Params p) {
  extern __shared__ __attribute__((aligned(16))) char smem[];
  phase1(p, smem);
}

struct EpiOut {
  const float* x0; const float* x1; float* out; int ct; int tok0;
  __device__ __forceinline__ void operator()(int m, int n, float v0, float v1, float v2, float v3) const {
    int tok = tok0 + n, col = ct * 256 + m;
    const float* xr = (tok < 32768) ? (x0 + (long)tok * 1024) : (x1 + (long)(tok - 32768) * 1024);
    float4 xv = *(const float4*)(xr + col);
    const float alpha = 1.189207115002721f;
    float4 o; o.x = alpha * xv.x + v0; o.y = alpha * xv.y + v1; o.z = alpha * xv.z + v2; o.w = alpha * xv.w + v3;
    *(float4*)(out + (long)tok * 1024 + col) = o;
  }
};

__device__ void phase4(const Params& p, char* smem) {
  const u16* mixed = (const u16*)(p.ws + OFF_MIXED);
  const u16* wb = (const u16*)(p.ws + OFF_WBOUT);
  const int lane = threadIdx.x & 63, w = threadIdx.x >> 6;
  for (int mt = blockIdx.x; mt < 256; mt += gridDim.x) {
    const int tok0 = mt * 256;
    for (int i = 0; i < 32; ++i) mixed_row(p, tok0 + w * 32 + i, lane);
    __syncthreads();
    for (int ct = 0; ct < 4; ++ct) {
      EpiOut e{p.x0, p.x1, p.out, ct, tok0};
      gemm_tile(wb + (long)ct * 256 * 1024, 1024, mixed + (long)tok0 * 1024, 1024, 1024, smem, e);
    }
    __syncthreads();
    for (int i = 0; i < 32; ++i) ln_row(p, tok0 + w * 32 + i, lane);
  }
}
__global__ void __launch_bounds__(512) k_phase4(Params p) {
  extern __shared__ __attribute__((aligned(16))) char smem[];
  phase4(p, smem);
}

#define HY_US_BYTES 68608
#define HY_LDS (HY_US_BYTES + 65664)

__device__ __forceinline__ uint4 conv8(const u16* __restrict__ row, int tau, int t, int L, float cb, float w0, float w1, float w2) {
  uint4 raw = *(const uint4*)(row + tau);
  float v[10];
  v[0] = (t > 0) ? bf2f(row[tau - 1]) : 0.f;
  v[1] = bflo(raw.x); v[2] = bfhi(raw.x); v[3] = bflo(raw.y); v[4] = bfhi(raw.y);
  v[5] = bflo(raw.z); v[6] = bfhi(raw.z); v[7] = bflo(raw.w); v[8] = bfhi(raw.w);
  v[9] = (t + 8 < L) ? bf2f(row[tau + 8]) : 0.f;
  float o[8];
#pragma unroll
  for (int j = 0; j < 8; ++j) o[j] = cb + w0 * v[j] + w1 * v[j + 1] + w2 * v[j + 2];
  uint4 r; r.x = pack2(o[0], o[1]); r.y = pack2(o[2], o[3]); r.z = pack2(o[4], o[5]); r.w = pack2(o[6], o[7]);
  return r;
}

__device__ void hyena_unit(const Params& p, int order, bool samp, int c, char* smem) {
  const int tid = threadIdx.x, lane = tid & 63, w = tid >> 6;
  const int L = samp ? 16384 : 4096;
  const int LSH = samp ? 14 : 12;
  const int NB = samp ? 2 : 8;
  const int NISH = samp ? 4 : 2;
  const int P = 32 << NISH;
  const int LG = samp ? LG_S : LG_P;
  const int tokbase = samp ? 32768 : 0;
  u16* us = (u16*)smem;
  u16* grl = (u16*)(smem + HY_US_BYTES);
  const u16* UT = (const u16*)(p.ws + OFF_UT);
  const u16* GRg = (const u16*)((char*)p.out + (samp ? OFF_GRS : OFF_GRP)) + (long)(order * 512 + c) * LG;
  const u16* usrc = (order == 0) ? (UT + (long)c * NTOK + tokbase)
                                 : ((const u16*)((char*)p.out + OFF_Z1T) + (long)c * NTOK + tokbase);
  const int gch = 512 * (order + 1) + c;
  const u16* gsrc = UT + (long)gch * NTOK + tokbase;
  u16* dst = ((order == 0) ? (u16*)((char*)p.out + OFF_Z1T) : (u16*)(p.ws + OFF_Z2T)) + (long)c * NTOK + tokbase;

  __syncthreads();
  for (int i = tid; i < LG / 8; i += 512) *(uint4*)(grl + i * 8) = *(const uint4*)(GRg + i * 8);
  {
    const int pc = P >> 3;
    const uint4 z4 = make_uint4(0, 0, 0, 0);
    for (int i = tid; i < (NB + 1) * pc; i += 512) {
      int g = i / pc, r = i - g * pc;
      *(uint4*)(us + g * (L + P) + r * 8) = z4;
    }
  }
  if (order == 0) {
    const float cb = p.conv_b[c], w0 = p.conv_w[c], w1 = p.conv_w[1536 + c], w2 = p.conv_w[3072 + c];
    for (int i = tid; i < 4096; i += 512) {
      int tau = i * 8, b = tau >> LSH, t = tau & (L - 1);
      *(uint4*)(us + P + b * (L + P) + t) = conv8(usrc, tau, t, L, cb, w0, w1, w2);
    }
  } else {
    for (int i = tid; i < 4096; i += 512) {
      int tau = i * 8, b = tau >> LSH, t = tau & (L - 1);
      *(uint4*)(us + P + b * (L + P) + t) = *(const uint4*)(usrc + tau);
    }
  }
  __syncthreads();

  const int n = lane & 31, h = lane >> 5;
  const int bat = n >> NISH, ii = n & ((1 << NISH) - 1);
  const int ubase = P + bat * (L + P) + 32 * ii + 8 * h;
  const int ebase = L + 32 - n + 8 * h;
  const unsigned sh = (unsigned)(ebase & 1) * 16u;
  f32x16 acc0, acc1, acc2, acc3;
#pragma unroll
  for (int j = 0; j < 16; ++j) { acc0[j] = 0.f; acc1[j] = 0.f; acc2[j] = 0.f; acc3[j] = 0.f; }
  const int o0 = P * 4 * w;
  const int base_lo = o0 - (L - 16);
  const int base_hi = o0 + 3 * P + (P - 32);
  const int smin = -(P - 32), smax = L - 16;
  for (int base = base_lo; base <= base_hi; base += 16) {
    const int E = ebase - base;
    const unsigned* gp = (const unsigned*)grl + (E >> 1);
    unsigned d0 = gp[0], d1 = gp[1], d2 = gp[2], d3 = gp[3], d4 = gp[4];
    union { unsigned u[4]; bf16x8 v; } A;
    A.u[0] = __builtin_amdgcn_alignbit(d1, d0, sh);
    A.u[1] = __builtin_amdgcn_alignbit(d2, d1, sh);
    A.u[2] = __builtin_amdgcn_alignbit(d3, d2, sh);
    A.u[3] = __builtin_amdgcn_alignbit(d4, d3, sh);
    const int st0 = o0 - base;
    if (st0 >= smin && st0 <= smax)
      acc0 = __builtin_amdgcn_mfma_f32_32x32x16_bf16(A.v, *(const bf16x8*)(us + ubase + st0), acc0, 0, 0, 0);
    const int st1 = st0 + P;
    if (st1 >= smin && st1 <= smax)
      acc1 = __builtin_amdgcn_mfma_f32_32x32x16_bf16(A.v, *(const bf16x8*)(us + ubase + st1), acc1, 0, 0, 0);
    const int st2 = st1 + P;
    if (st2 >= smin && st2 <= smax)
      acc2 = __builtin_amdgcn_mfma_f32_32x32x16_bf16(A.v, *(const bf16x8*)(us + ubase + st2), acc2, 0, 0, 0);
    const int st3 = st2 + P;
    if (st3 >= smin && st3 <= smax)
      acc3 = __builtin_amdgcn_mfma_f32_32x32x16_bf16(A.v, *(const bf16x8*)(us + ubase + st3), acc3, 0, 0, 0);
  }
  __syncthreads();
  {
    const float cb = p.conv_b[gch], w0 = p.conv_w[gch], w1 = p.conv_w[1536 + gch], w2 = p.conv_w[3072 + gch];
    for (int i = tid; i < 4096; i += 512) {
      int tau = i * 8, t = tau & (L - 1);
      *(uint4*)(grl + tau) = conv8(gsrc, tau, t, L, cb, w0, w1, w2);
    }
  }
  __syncthreads();
  const float dv = p.hyd[order * 512 + c];
#define HY_EPI(ACC, R) do { \
    _Pragma("unroll") for (int g4 = 0; g4 < 4; ++g4) { \
      int t = o0 + P * (R) + 8 * g4 + 4 * h + 32 * ii; \
      int tau = (bat << LSH) + t; \
      uint2 uu = *(const uint2*)(us + P + bat * (L + P) + t); \
      uint2 gg = *(const uint2*)(grl + tau); \
      float y0 = bflo(gg.x) * (ACC[4 * g4 + 0] + dv * bflo(uu.x)); \
      float y1 = bfhi(gg.x) * (ACC[4 * g4 + 1] + dv * bfhi(uu.x)); \
      float y2 = bflo(gg.y) * (ACC[4 * g4 + 2] + dv * bflo(uu.y)); \
      float y3 = bfhi(gg.y) * (ACC[4 * g4 + 3] + dv * bfhi(uu.y)); \
      uint2 oo; oo.x = pack2(y0, y1); oo.y = pack2(y2, y3); \
      *(uint2*)(dst + tau) = oo; \
    } } while (0)
  HY_EPI(acc0, 0); HY_EPI(acc1, 1); HY_EPI(acc2, 2); HY_EPI(acc3, 3);
}

__device__ void hyena_phase(const Params& p, int order, char* smem) {
  for (int b = blockIdx.x; b < 256; b += gridDim.x) {
    hyena_unit(p, order, true, b, smem);
    hyena_unit(p, order, true, b + 256, smem);
    hyena_unit(p, order, false, b, smem);
    hyena_unit(p, order, false, b + 256, smem);
  }
}
__global__ void __launch_bounds__(512) k_hyena(Params p, int order) {
  extern __shared__ __attribute__((aligned(16))) char smem[];
  hyena_phase(p, order, smem);
}

__device__ void attn_naive_phase(const Params& p) {
  for (int gid = blockIdx.x * 512 + threadIdx.x; gid < 65536 * 8; gid += gridDim.x * 512) {
    int tok = gid & 65535, head = gid >> 16;
    int t, L, sb; tok_info(tok, t, L, sb);
    u16* Qb = (u16*)(p.ws + OFF_QB);
    const u16* Kb = (const u16*)(p.ws + OFF_KB);
    const u16* Vb = (const u16*)(p.ws + OFF_VB);
    float q[64], o[64];
#pragma unroll
    for (int d = 0; d < 64; ++d) { q[d] = bf2f(Qb[(long)tok * 512 + head * 64 + d]); o[d] = 0.f; }
    float m = -1e30f, l = 0.f;
    const float slope2 = exp2f(-(float)(head + 1)) * LOG2E;
    for (int pat = 0; pat < 3; ++pat) {
      int dil = (pat == 0) ? 1 : (pat == 1 ? 4 : 16);
      for (int j = -64; j <= 64; ++j) {
        int tk = t + j * dil;
        if (tk < 0 || tk >= L) continue;
        const u16* kr = Kb + (long)(sb + tk) * 512 + head * 64;
        const u16* vr = Vb + (long)(sb + tk) * 512 + head * 64;
        float s = 0.f;
#pragma unroll
        for (int d = 0; d < 64; ++d) s += q[d] * bf2f(kr[d]);
        s -= slope2 * (float)(abs(j) * dil);
        if (s > m) {
          float sc = exp2f(m - s);
          l *= sc;
#pragma unroll
          for (int d = 0; d < 64; ++d) o[d] *= sc;
          m = s;
        }
        float pr = exp2f(s - m);
        l += pr;
#pragma unroll
        for (int d = 0; d < 64; ++d) o[d] += pr * bf2f(vr[d]);
      }
    }
    float inv = 1.f / l;
#pragma unroll
    for (int d = 0; d < 64; ++d) Qb[(long)tok * 512 + head * 64 + d] = f2bf(o[d] * inv);
  }
}

#ifndef ATTN_PHASE
#define ATTN_PHASE(p, smem) attn_naive_phase(p)
#endif

__global__ void __launch_bounds__(512) mega(Params p) {
  extern __shared__ __attribute__((aligned(16))) char smem[];
  cg::grid_group grid = cg::this_grid();
  phase0(p, smem);
  grid.sync();
  phase1(p, smem);
  grid.sync();
  hyena_phase(p, 0, smem);
  ATTN_PHASE(p, smem);
  grid.sync();
  convert_wout(p);
  hyena_phase(p, 1, smem);
  grid.sync();
  phase4(p, smem);
}

static Params make_params(void* const* d_in, void* d_out, void* d_ws) {
  Params p{};
  p.x0 = (const float*)d_in[0]; p.x1 = (const float*)d_in[1]; p.w_in = (const float*)d_in[2];
  p.conv_w = (const float*)d_in[3]; p.conv_b = (const float*)d_in[4];
  p.fw1 = (const float*)d_in[5]; p.fb1 = (const float*)d_in[6]; p.fw2 = (const float*)d_in[7]; p.fb2 = (const float*)d_in[8];
  p.fw3 = (const float*)d_in[9]; p.fb3 = (const float*)d_in[10]; p.ffreq = (const float*)d_in[11]; p.fw4 = (const float*)d_in[12];
  p.hyd = (const float*)d_in[13]; p.gna = (const float*)d_in[14]; p.gnh = (const float*)d_in[15];
  p.w_out = (const float*)d_in[16]; p.lng = (const float*)d_in[17]; p.lnb = (const float*)d_in[18];
  p.out = (float*)d_out; p.ws = (char*)d_ws;
  return p;
}

extern "C" void kernel_launch(void* const* d_in, const int* in_sizes, int n_in,
                              void* d_out, int out_size, void* d_ws, size_t ws_size,
                              hipStream_t stream) {
  Params p = make_params(d_in, d_out, d_ws);
  static int grid_blocks = 0;
  if (!grid_blocks) {
    (void)hipFuncSetAttribute((const void*)mega, hipFuncAttributeMaxDynamicSharedMemorySize, GEMM_LDS);
    int dev = 0, cus = 0, per_cu = 0;
    (void)hipGetDevice(&dev);
    (void)hipDeviceGetAttribute(&cus, hipDeviceAttributeMultiprocessorCount, dev);
    (void)hipOccupancyMaxActiveBlocksPerMultiprocessor(&per_cu, mega, 512, GEMM_LDS);
    if (per_cu < 1) per_cu = 1;
    grid_blocks = cus;
    if (grid_blocks > 256) grid_blocks = 256;
  }
  void* args[] = {&p};
  hipError_t e = hipLaunchCooperativeKernel((void*)mega, dim3(grid_blocks), dim3(512), args, GEMM_LDS, stream);
  if (e != hipSuccess) fprintf(stderr, "cooperative launch failed: %s (grid %d)\n", hipGetErrorString(e), grid_blocks);
}
```

```cpp
#include <hip/hip_runtime.h>
#include <hip/hip_cooperative_groups.h>
#include <cstdio>
namespace cg = cooperative_groups;

typedef unsigned short u16;
typedef short bf16x8 __attribute__((ext_vector_type(8)));
typedef short s16x4 __attribute__((ext_vector_type(4)));
typedef float f32x16 __attribute__((ext_vector_type(16)));

#define NTOK 65536
#define MiB (1024L * 1024L)
#define OFF_QB (0 * MiB)
#define OFF_KB (64 * MiB)
#define OFF_VB (128 * MiB)
#define OFF_GB (192 * MiB)
#define OFF_UT (320 * MiB)
#define OFF_MIXED (64 * MiB)
#define OFF_WBOUT (384 * MiB)
#define OFF_Z2T (320 * MiB)
#define OFF_XB (0 * MiB)
#define OFF_Z1T (0 * MiB)
#define OFF_Z0T (64 * MiB)
#define LG_S 32832
#define LG_P 8256
#define OFF_GRS (128 * MiB)
#define OFF_GRP (128 * MiB + 1024L * LG_S * 2)
#define OFF_WBIN (212 * MiB)

struct Params {
  const float *x0, *x1, *w_in, *conv_w, *conv_b, *fw1, *fb1, *fw2, *fb2, *fw3, *fb3, *ffreq, *fw4, *hyd, *gna, *gnh, *w_out, *lng, *lnb;
  float* out;
  char* ws;
};

__device__ __forceinline__ u16 f2bf(float f) {
  unsigned u = __float_as_uint(f);
  u += 0x7fffu + ((u >> 16) & 1u);
  return (u16)(u >> 16);
}
__device__ __forceinline__ float bf2f(u16 b) { return __uint_as_float(((unsigned)b) << 16); }
__device__ __forceinline__ unsigned pack2(float a, float b) { return (unsigned)f2bf(a) | ((unsigned)f2bf(b) << 16); }
__device__ __forceinline__ float bflo(unsigned u) { return __uint_as_float(u << 16); }
__device__ __forceinline__ float bfhi(unsigned u) { return __uint_as_float(u & 0xffff0000u); }
__device__ __forceinline__ float silu_f(float x) { return x / (1.f + __expf(-x)); }

__device__ __forceinline__ void tok_info(int tok, int& t, int& L, int& seqbase) {
  if (tok < 32768) { L = 4096; t = tok & 4095; seqbase = tok & ~4095; }
  else { L = 16384; t = tok & 16383; seqbase = tok & ~16383; }
}

__device__ void filter_item(const Params& p, int item, char* smem) {
  const int tid = threadIdx.x;
  const bool samp = item < 512;
  const int L = samp ? 16384 : 4096;
  const int LG = samp ? LG_S : LG_P;
  const int l0 = (samp ? item : item - 512) * 32;
  u16* GR = (u16*)((char*)p.out + (samp ? OFF_GRS : OFF_GRP));
  float* zs = (float*)smem;
  float* ha = zs + 32 * 36;
  float* hb = ha + 32 * 64;
  __syncthreads();
  for (int i = tid; i < 32 * 33; i += 512) {
    int l = i / 33, f = i - l * 33;
    int lag = l0 + l;
    float t = (float)lag / (float)(L - 1);
    float w = (float)lag / (float)L;
    float v;
    if (f == 0) v = t;
    else {
      int j = (f - 1) & 15;
      float fr = 1e-4f + (float)j * ((15.0f - 1e-4f) / 15.0f);
      float a = fr * w;
      v = (f <= 16) ? __builtin_amdgcn_cosf(a) : -__builtin_amdgcn_sinf(a);
    }
    zs[l * 36 + f] = v;
  }
  __syncthreads();
#pragma unroll 1
  for (int q = 0; q < 4; ++q) {
    int o = tid + 512 * q; int l = o >> 6, u = o & 63;
    float acc = p.fb1[u];
#pragma unroll 3
    for (int f = 0; f < 33; ++f) acc += zs[l * 36 + f] * p.fw1[f * 64 + u];
    ha[l * 64 + u] = __sinf(p.ffreq[u] * acc);
  }
  __syncthreads();
#pragma unroll 1
  for (int q = 0; q < 4; ++q) {
    int o = tid + 512 * q; int l = o >> 6, u = o & 63;
    float acc = p.fb2[u];
#pragma unroll 4
    for (int f = 0; f < 64; ++f) acc += ha[l * 64 + f] * p.fw2[f * 64 + u];
    hb[l * 64 + u] = __sinf(p.ffreq[64 + u] * acc);
  }
  __syncthreads();
#pragma unroll 1
  for (int q = 0; q < 4; ++q) {
    int o = tid + 512 * q; int l = o >> 6, u = o & 63;
    float acc = p.fb3[u];
#pragma unroll 4
    for (int f = 0; f < 64; ++f) acc += hb[l * 64 + f] * p.fw3[f * 64 + u];
    ha[l * 64 + u] = __sinf(p.ffreq[128 + u] * acc);
  }
  __syncthreads();
  const int c = tid;
  const float min_decay = -3.0701134573253943f;
  const float max_decay = -15.350567286626972f;
  const float delta = fabsf(min_decay + (max_decay - min_decay) * ((float)c / 511.0f));
#pragma unroll 1
  for (int lh = 0; lh < 4; ++lh) {
    float acc[8][4];
#pragma unroll
    for (int l = 0; l < 8; ++l)
#pragma unroll
      for (int q = 0; q < 4; ++q) acc[l][q] = 0.f;
#pragma unroll 2
    for (int j = 0; j < 64; ++j) {
      float wv[4];
#pragma unroll
      for (int q = 0; q < 4; ++q) wv[q] = p.fw4[j * 2048 + q * 512 + c];
#pragma unroll
      for (int l = 0; l < 8; ++l) {
        float hv = ha[(lh * 8 + l) * 64 + j];
#pragma unroll
        for (int q = 0; q < 4; ++q) acc[l][q] += hv * wv[q];
      }
    }
#pragma unroll
    for (int l = 0; l < 8; ++l) {
      int lag = l0 + lh * 8 + l;
      float t = (float)lag / (float)(L - 1);
      float dec = expf(-t * delta);
#pragma unroll
      for (int q = 0; q < 4; ++q) {
        int n = q >> 1, dir = q & 1;
        long row = (long)(n * 512 + c) * LG;
        if (dir == 0) GR[row + (L + 32 - lag)] = f2bf(acc[l][q] * dec);
        else if (lag > 0) GR[row + (L + 32 + lag)] = f2bf(acc[l][q] * dec);
      }
    }
  }
  if (l0 == 0) {
    for (int rr = 0; rr < 2; ++rr) {
      long row = (long)(tid + 512 * rr) * LG;
      for (int i = 0; i <= 32; ++i) GR[row + i] = 0;
      for (int i = 0; i < 32; ++i) GR[row + 2 * L + 32 + i] = 0;
    }
  }
}

__device__ void phase0(const Params& p, char* smem) {
  const int tid = threadIdx.x, bid = blockIdx.x, nb = gridDim.x;
  u16* xb = (u16*)((char*)p.out + OFF_XB);
  const long nchunk = (long)NTOK * 1024 / 8;
  for (long cidx = (long)bid * 512 + tid; cidx < nchunk; cidx += (long)nb * 512) {
    long e = cidx * 8;
    const float* src = (e < 32768L * 1024) ? (p.x0 + e) : (p.x1 + (e - 32768L * 1024));
    float4 a = *(const float4*)src, b = *(const float4*)(src + 4);
    uint4 o;
    o.x = pack2(a.x, a.y); o.y = pack2(a.z, a.w); o.z = pack2(b.x, b.y); o.w = pack2(b.z, b.w);
    *(uint4*)(xb + e) = o;
  }
  u16* wbin = (u16*)((char*)p.out + OFF_WBIN);
  for (int id = bid * 512 + tid; id < 4096 * 128; id += nb * 512) {
    int n = id & 4095, kc = id >> 12;
    float v[8];
#pragma unroll
    for (int j = 0; j < 8; ++j) v[j] = p.w_in[(long)(kc * 8 + j) * 4096 + n];
    uint4 o;
    o.x = pack2(v[0], v[1]); o.y = pack2(v[2], v[3]); o.z = pack2(v[4], v[5]); o.w = pack2(v[6], v[7]);
    *(uint4*)(wbin + (long)n * 1024 + kc * 8) = o;
  }
  for (int item = bid; item < 640; item += nb) filter_item(p, item, smem);
}

__device__ void convert_wout(const Params& p) {
  const int tid = threadIdx.x, bid = blockIdx.x, nb = gridDim.x;
  u16* wb = (u16*)(p.ws + OFF_WBOUT);
  for (int id = bid * 512 + tid; id < 1024 * 128; id += nb * 512) {
    int n = id & 1023, kc = id >> 10;
    float v[8];
#pragma unroll
    for (int j = 0; j < 8; ++j) v[j] = p.w_out[(long)(kc * 8 + j) * 1024 + n];
    uint4 o;
    o.x = pack2(v[0], v[1]); o.y = pack2(v[2], v[3]); o.z = pack2(v[4], v[5]); o.w = pack2(v[6], v[7]);
    *(uint4*)(wb + (long)n * 1024 + kc * 8) = o;
  }
}

#define QSCALE 0.18033688011112042f
#define LOG2E 1.4426950408889634f

__device__ __forceinline__ void inproj_store1(const Params& p, int tok, int col, float v) {
  u16* ws16 = (u16*)p.ws;
  if (col < 512) ws16[(OFF_QB >> 1) + (long)tok * 512 + col] = f2bf(v * QSCALE);
  else if (col < 1024) ws16[(OFF_KB >> 1) + (long)tok * 512 + (col - 512)] = f2bf(v);
  else if (col < 1536) ws16[(OFF_VB >> 1) + (long)tok * 512 + (col - 1024)] = f2bf(v);
  else if (col < 2048) ws16[(OFF_GB >> 1) + (long)tok * 1024 + (col - 1536)] = f2bf(silu_f(v));
  else if (col < 3584) ws16[(OFF_UT >> 1) + (long)(col - 2048) * NTOK + tok] = f2bf(v);
  else ws16[(OFF_GB >> 1) + (long)tok * 1024 + 512 + (col - 3584)] = f2bf(silu_f(v));
}

__device__ __forceinline__ float shortconv_at(const Params& p, int ch, int tok) {
  const u16* row = (const u16*)(p.ws + OFF_UT) + (long)ch * NTOK;
  int t, L, sb; tok_info(tok, t, L, sb);
  float a = (t > 0) ? bf2f(row[tok - 1]) : 0.f;
  float b = bf2f(row[tok]);
  float c = (t < L - 1) ? bf2f(row[tok + 1]) : 0.f;
  return p.conv_b[ch] + p.conv_w[ch] * a + p.conv_w[1536 + ch] * b + p.conv_w[3072 + ch] * c;
}

__global__ void __launch_bounds__(512) k_phase0(Params p) {
  extern __shared__ __attribute__((aligned(16))) char smem[];
  phase0(p, smem);
}
__global__ void __launch_bounds__(512) k_convert_wout(Params p) { convert_wout(p); }

__global__ void __launch_bounds__(256) n_inproj(Params p) {
  long gid = (long)blockIdx.x * 256 + threadIdx.x;
  int col = (int)(gid & 4095), tok = (int)(gid >> 12);
  const u16* xb = (const u16*)((char*)p.out + OFF_XB) + (long)tok * 1024;
  const u16* wb = (const u16*)((char*)p.out + OFF_WBIN) + (long)col * 1024;
  float acc = 0.f;
  for (int k = 0; k < 1024; k += 8) {
    uint4 a = *(const uint4*)(xb + k), b = *(const uint4*)(wb + k);
    acc += bflo(a.x) * bflo(b.x) + bfhi(a.x) * bfhi(b.x) + bflo(a.y) * bflo(b.y) + bfhi(a.y) * bfhi(b.y)
         + bflo(a.z) * bflo(b.z) + bfhi(a.z) * bfhi(b.z) + bflo(a.w) * bflo(b.w) + bfhi(a.w) * bfhi(b.w);
  }
  inproj_store1(p, tok, col, acc);
}

__global__ void __launch_bounds__(256) n_attn(Params p) {
  int gid = blockIdx.x * 256 + threadIdx.x;
  int tok = gid & 65535, head = gid >> 16;
  int t, L, sb; tok_info(tok, t, L, sb);
  u16* Qb = (u16*)(p.ws + OFF_QB);
  const u16* Kb = (const u16*)(p.ws + OFF_KB);
  const u16* Vb = (const u16*)(p.ws + OFF_VB);
  float q[64], o[64];
#pragma unroll
  for (int d = 0; d < 64; ++d) { q[d] = bf2f(Qb[(long)tok * 512 + head * 64 + d]); o[d] = 0.f; }
  float m = -1e30f, l = 0.f;
  const float slope2 = exp2f(-(float)(head + 1)) * LOG2E;
  for (int pat = 0; pat < 3; ++pat) {
    int dil = (pat == 0) ? 1 : (pat == 1 ? 4 : 16);
    for (int j = -64; j <= 64; ++j) {
      int tk = t + j * dil;
      if (tk < 0 || tk >= L) continue;
      const u16* kr = Kb + (long)(sb + tk) * 512 + head * 64;
      const u16* vr = Vb + (long)(sb + tk) * 512 + head * 64;
      float s = 0.f;
#pragma unroll
      for (int d = 0; d < 64; ++d) s += q[d] * bf2f(kr[d]);
      s -= slope2 * (float)(abs(j) * dil);
      if (s > m) {
        float sc = exp2f(m - s);
        l *= sc;
#pragma unroll
        for (int d = 0; d < 64; ++d) o[d] *= sc;
        m = s;
      }
      float pr = exp2f(s - m);
      l += pr;
#pragma unroll
      for (int d = 0; d < 64; ++d) o[d] += pr * bf2f(vr[d]);
    }
  }
  float inv = 1.f / l;
#pragma unroll
  for (int d = 0; d < 64; ++d) Qb[(long)tok * 512 + head * 64 + d] = f2bf(o[d] * inv);
}

__global__ void __launch_bounds__(256) n_z0(Params p) {
  int gid = blockIdx.x * 256 + threadIdx.x;
  int tok = gid & 65535, c = gid >> 16;
  u16* z0 = (u16*)((char*)p.out + OFF_Z0T);
  z0[(long)c * NTOK + tok] = f2bf(shortconv_at(p, c, tok));
}

__global__ void __launch_bounds__(256) n_conv(Params p, int order) {
  int gid = blockIdx.x * 256 + threadIdx.x;
  int tok = gid & 65535, c = gid >> 16;
  int t, L, sb; tok_info(tok, t, L, sb);
  const bool samp = tok >= 32768;
  const u16* src = (order == 0) ? (const u16*)((char*)p.out + OFF_Z0T) : (const u16*)((char*)p.out + OFF_Z1T);
  const u16* urow = src + (long)c * NTOK + sb;
  const u16* gr = (const u16*)((char*)p.out + (samp ? OFF_GRS : OFF_GRP)) + (long)(order * 512 + c) * (samp ? LG_S : LG_P);
  const u16* g0 = gr + (L + 32 - t);
  float y = 0.f;
  for (int s = 0; s < L; ++s) y += bf2f(g0[s]) * bf2f(urow[s]);
  float gate = shortconv_at(p, 512 * (order + 1) + c, tok);
  float dv = p.hyd[order * 512 + c];
  float r = gate * (y + dv * bf2f(urow[t]));
  u16* dst = (order == 0) ? (u16*)((char*)p.out + OFF_Z1T) : (u16*)(p.ws + OFF_Z2T);
  dst[(long)c * NTOK + tok] = f2bf(r);
}

__global__ void __launch_bounds__(256) n_outproj(Params p) {
  long gid = (long)blockIdx.x * 256 + threadIdx.x;
  int col = (int)(gid & 1023), tok = (int)(gid >> 10);
  const u16* a = (const u16*)(p.ws + OFF_MIXED) + (long)tok * 1024;
  const u16* wb = (const u16*)(p.ws + OFF_WBOUT) + (long)col * 1024;
  float acc = 0.f;
  for (int k = 0; k < 1024; k += 8) {
    uint4 x = *(const uint4*)(a + k), b = *(const uint4*)(wb + k);
    acc += bflo(x.x) * bflo(b.x) + bfhi(x.x) * bfhi(b.x) + bflo(x.y) * bflo(b.y) + bfhi(x.y) * bfhi(b.y)
         + bflo(x.z) * bflo(b.z) + bfhi(x.z) * bfhi(b.z) + bflo(x.w) * bflo(b.w) + bfhi(x.w) * bfhi(b.w);
  }
  const float* xr = (tok < 32768) ? (p.x0 + (long)tok * 1024) : (p.x1 + (long)(tok - 32768) * 1024);
  p.out[(long)tok * 1024 + col] = 1.189207115002721f * xr[col] + acc;
}

__device__ __forceinline__ float wave_sum(float v) {
#pragma unroll
  for (int o = 32; o; o >>= 1) v += __shfl_xor(v, o);
  return v;
}

__device__ __forceinline__ void mixed_row(const Params& p, int tok, int lane) {
  u16* mixed = (u16*)(p.ws + OFF_MIXED) + (long)tok * 1024;
  const u16* Gb = (const u16*)(p.ws + OFF_GB) + (long)tok * 1024;
  {
    uint4 a = *(const uint4*)((const u16*)(p.ws + OFF_QB) + (long)tok * 512 + lane * 8);
    float v[8] = {bflo(a.x), bfhi(a.x), bflo(a.y), bfhi(a.y), bflo(a.z), bfhi(a.z), bflo(a.w), bfhi(a.w)};
    float ssq = 0.f;
#pragma unroll
    for (int j = 0; j < 8; ++j) ssq += v[j] * v[j];
    ssq = wave_sum(ssq);
    float r = rsqrtf(ssq * (1.f / 512.f) + 1e-6f);
    uint4 g = *(const uint4*)(Gb + lane * 8);
    float sg[8] = {bflo(g.x), bfhi(g.x), bflo(g.y), bfhi(g.y), bflo(g.z), bfhi(g.z), bflo(g.w), bfhi(g.w)};
    float4 n0 = *(const float4*)(p.gna + lane * 8), n1 = *(const float4*)(p.gna + lane * 8 + 4);
    float gn[8] = {n0.x, n0.y, n0.z, n0.w, n1.x, n1.y, n1.z, n1.w};
    float o[8];
#pragma unroll
    for (int j = 0; j < 8; ++j) o[j] = v[j] * r * gn[j] * sg[j];
    uint4 w; w.x = pack2(o[0], o[1]); w.y = pack2(o[2], o[3]); w.z = pack2(o[4], o[5]); w.w = pack2(o[6], o[7]);
    *(uint4*)(mixed + lane * 8) = w;
  }
  {
    const u16* z2 = (const u16*)(p.ws + OFF_Z2T);
    float v[8];
    float ssq = 0.f;
#pragma unroll
    for (int j = 0; j < 8; ++j) { v[j] = bf2f(z2[(long)(lane * 8 + j) * NTOK + tok]); ssq += v[j] * v[j]; }
    ssq = wave_sum(ssq);
    float r = rsqrtf(ssq * (1.f / 512.f) + 1e-6f);
    uint4 g = *(const uint4*)(Gb + 512 + lane * 8);
    float sg[8] = {bflo(g.x), bfhi(g.x), bflo(g.y), bfhi(g.y), bflo(g.z), bfhi(g.z), bflo(g.w), bfhi(g.w)};
    float4 n0 = *(const float4*)(p.gnh + lane * 8), n1 = *(const float4*)(p.gnh + lane * 8 + 4);
    float gn[8] = {n0.x, n0.y, n0.z, n0.w, n1.x, n1.y, n1.z, n1.w};
    float o[8];
#pragma unroll
    for (int j = 0; j < 8; ++j) o[j] = v[j] * r * gn[j] * sg[j];
    uint4 w; w.x = pack2(o[0], o[1]); w.y = pack2(o[2], o[3]); w.z = pack2(o[4], o[5]); w.w = pack2(o[6], o[7]);
    *(uint4*)(mixed + 512 + lane * 8) = w;
  }
}

__device__ __forceinline__ void ln_row(const Params& p, int tok, int lane) {
  float* row = p.out + (long)tok * 1024;
  float4 v[4];
  float s = 0.f;
#pragma unroll
  for (int q = 0; q < 4; ++q) { v[q] = *(const float4*)(row + q * 256 + lane * 4); s += v[q].x + v[q].y + v[q].z + v[q].w; }
  s = wave_sum(s);
  float mu = s * (1.f / 1024.f);
  float ss = 0.f;
#pragma unroll
  for (int q = 0; q < 4; ++q) {
    float a = v[q].x - mu, b = v[q].y - mu, c = v[q].z - mu, d = v[q].w - mu;
    ss += a * a + b * b + c * c + d * d;
  }
  ss = wave_sum(ss);
  float rstd = rsqrtf(ss * (1.f / 1024.f) + 1e-5f);
#pragma unroll
  for (int q = 0; q < 4; ++q) {
    float4 g = *(const float4*)(p.lng + q * 256 + lane * 4), b = *(const float4*)(p.lnb + q * 256 + lane * 4);
    float4 o;
    o.x = (v[q].x - mu) * rstd * g.x + b.x; o.y = (v[q].y - mu) * rstd * g.y + b.y;
    o.z = (v[q].z - mu) * rstd * g.z + b.z; o.w = (v[q].w - mu) * rstd * g.w + b.w;
    *(float4*)(row + q * 256 + lane * 4) = o;
  }
}

__global__ void __launch_bounds__(512) k_mixed(Params p) {
  int tok = blockIdx.x * 8 + (threadIdx.x >> 6);
  mixed_row(p, tok, threadIdx.x & 63);
}
__global__ void __launch_bounds__(512) k_ln(Params p) {
  int tok = blockIdx.x * 8 + (threadIdx.x >> 6);
  ln_row(p, tok, threadIdx.x & 63);
}

#define LDSROW 144
#define TILEB (256 * LDSROW)
#define GEMM_LDS (4 * TILEB)

template <class Epi>
__device__ __forceinline__ void gemm_tile(const u16* __restrict__ A, long lda, const u16* __restrict__ B, long ldb,
                                          int K, char* smem, Epi& epi) {
  const int tid = threadIdx.x, lane = tid & 63, w = tid >> 6, wm = w >> 2, wn = w & 3;
  const int l31 = lane & 31, h = lane >> 5;
  f32x16 acc[4][2];
#pragma unroll
  for (int mi = 0; mi < 4; ++mi)
#pragma unroll
    for (int ni = 0; ni < 2; ++ni)
#pragma unroll
      for (int j = 0; j < 16; ++j) acc[mi][ni][j] = 0.f;
  uint4 ra0, ra1, ra2, ra3, rb0, rb1, rb2, rb3;
  const int srow = tid >> 3, skc = tid & 7;
  const u16* Ag = A + (long)srow * lda + skc * 8;
  const u16* Bg = B + (long)srow * ldb + skc * 8;
  const int soff = srow * LDSROW + skc * 16;
  const int nk = K >> 6;
#define GLD(kk) do { \
    ra0 = *(const uint4*)(Ag + (kk)); ra1 = *(const uint4*)(Ag + 64 * lda + (kk)); ra2 = *(const uint4*)(Ag + 128 * lda + (kk)); ra3 = *(const uint4*)(Ag + 192 * lda + (kk)); \
    rb0 = *(const uint4*)(Bg + (kk)); rb1 = *(const uint4*)(Bg + 64 * ldb + (kk)); rb2 = *(const uint4*)(Bg + 128 * ldb + (kk)); rb3 = *(const uint4*)(Bg + 192 * ldb + (kk)); } while (0)
#define SST(d) do { \
    *(uint4*)((d) + soff) = ra0; *(uint4*)((d) + soff + 64 * LDSROW) = ra1; *(uint4*)((d) + soff + 128 * LDSROW) = ra2; *(uint4*)((d) + soff + 192 * LDSROW) = ra3; \
    *(uint4*)((d) + TILEB + soff) = rb0; *(uint4*)((d) + TILEB + soff + 64 * LDSROW) = rb1; *(uint4*)((d) + TILEB + soff + 128 * LDSROW) = rb2; *(uint4*)((d) + TILEB + soff + 192 * LDSROW) = rb3; } while (0)
  GLD(0);
  __syncthreads();
  SST(smem);
  __syncthreads();
  for (int kt = 0; kt < nk; ++kt) {
    if (kt + 1 < nk) GLD((kt + 1) * 64);
    const char* a = smem + (kt & 1) * 2 * TILEB;
    const char* b = a + TILEB;
#pragma unroll
    for (int ks = 0; ks < 4; ++ks) {
      bf16x8 af[4], bfr[2];
#pragma unroll
      for (int mi = 0; mi < 4; ++mi) af[mi] = *(const bf16x8*)(a + (wm * 128 + mi * 32 + l31) * LDSROW + ks * 32 + h * 16);
#pragma unroll
      for (int ni = 0; ni < 2; ++ni) bfr[ni] = *(const bf16x8*)(b + (wn * 64 + ni * 32 + l31) * LDSROW + ks * 32 + h * 16);
#pragma unroll
      for (int mi = 0; mi < 4; ++mi)
#pragma unroll
        for (int ni = 0; ni < 2; ++ni)
          acc[mi][ni] = __builtin_amdgcn_mfma_f32_32x32x16_bf16(af[mi], bfr[ni], acc[mi][ni], 0, 0, 0);
    }
    if (kt + 1 < nk) {
      char* d = smem + ((kt + 1) & 1) * 2 * TILEB;
      SST(d);
    }
    __syncthreads();
  }
#pragma unroll
  for (int mi = 0; mi < 4; ++mi)
#pragma unroll
    for (int ni = 0; ni < 2; ++ni)
#pragma unroll
      for (int g = 0; g < 4; ++g)
        epi(wm * 128 + mi * 32 + 8 * g + 4 * h, wn * 64 + ni * 32 + l31,
            acc[mi][ni][4 * g], acc[mi][ni][4 * g + 1], acc[mi][ni][4 * g + 2], acc[mi][ni][4 * g + 3]);
}

struct EpiTokMajor {
  char* ws; int nt; int tok0;
  __device__ __forceinline__ void operator()(int m, int n, float v0, float v1, float v2, float v3) const {
    int tok = tok0 + n;
    int col = nt * 256 + m;
    u16* dst;
    if (col < 512) { dst = (u16*)(ws + OFF_QB) + (long)tok * 512 + col; v0 *= QSCALE; v1 *= QSCALE; v2 *= QSCALE; v3 *= QSCALE; }
    else if (col < 1024) dst = (u16*)(ws + OFF_KB) + (long)tok * 512 + (col - 512);
    else if (col < 1536) dst = (u16*)(ws + OFF_VB) + (long)tok * 512 + (col - 1024);
    else {
      int gc = (col < 2048) ? (col - 1536) : (512 + col - 3584);
      dst = (u16*)(ws + OFF_GB) + (long)tok * 1024 + gc;
      v0 = silu_f(v0); v1 = silu_f(v1); v2 = silu_f(v2); v3 = silu_f(v3);
    }
    uint2 o; o.x = pack2(v0, v1); o.y = pack2(v2, v3);
    *(uint2*)dst = o;
  }
};
struct EpiChanMajor {
  char* ws; int ch0; int tok0;
  __device__ __forceinline__ void operator()(int m, int n, float v0, float v1, float v2, float v3) const {
    u16* dst = (u16*)(ws + OFF_UT) + (long)(ch0 + n) * NTOK + tok0 + m;
    uint2 o; o.x = pack2(v0, v1); o.y = pack2(v2, v3);
    *(uint2*)dst = o;
  }
};

__device__ void phase1(const Params& p, char* smem) {
  const u16* xb = (const u16*)((char*)p.out + OFF_XB);
  const u16* wb = (const u16*)((char*)p.out + OFF_WBIN);
  for (int mt = blockIdx.x; mt < 256; mt += gridDim.x) {
    const int tok0 = mt * 256;
    for (int nt = 0; nt < 16; ++nt) {
      if (nt >= 8 && nt < 14) {
        EpiChanMajor e{p.ws, (nt - 8) * 256, tok0};
        gemm_tile(xb + (long)tok0 * 1024, 1024, wb + (long)nt * 256 * 1024, 1024, 1024, smem, e);
      } else {
        EpiTokMajor e{p.ws, nt, tok0};
        gemm_tile(wb + (long)nt * 256 * 1024, 1024, xb + (long)tok0 * 1024, 1024, 1024, smem, e);
      }
    }
  }
}
__global__ void __launch_bounds__(512) k_phase1(Params p) {
  extern __shared__ __attribute__((aligned(16))) char smem[];
  phase1(p, smem);
}

struct EpiOut {
  const float* x0; const float* x1; float* out; int ct; int tok0;
  __device__ __forceinline__ void operator()(int m, int n, float v0, float v1, float v2, float v3) const {
    int tok = tok0 + n, col = ct * 256 + m;
    const float* xr = (tok < 32768) ? (x0 + (long)tok * 1024) : (x1 + (long)(tok - 32768) * 1024);
    float4 xv = *(const float4*)(xr + col);
    const float alpha = 1.189207115002721f;
    float4 o; o.x = alpha * xv.x + v0; o.y = alpha * xv.y + v1; o.z = alpha * xv.z + v2; o.w = alpha * xv.w + v3;
    *(float4*)(out + (long)tok * 1024 + col) = o;
  }
};

__device__ void phase4(const Params& p, char* smem) {
  const u16* mixed = (const u16*)(p.ws + OFF_MIXED);
  const u16* wb = (const u16*)(p.ws + OFF_WBOUT);
  const int lane = threadIdx.x & 63, w = threadIdx.x >> 6;
  for (int mt = blockIdx.x; mt < 256; mt += gridDim.x) {
    const int tok0 = mt * 256;
    for (int i = 0; i < 32; ++i) mixed_row(p, tok0 + w * 32 + i, lane);
    __syncthreads();
    for (int ct = 0; ct < 4; ++ct) {
      EpiOut e{p.x0, p.x1, p.out, ct, tok0};
      gemm_tile(wb + (long)ct * 256 * 1024, 1024, mixed + (long)tok0 * 1024, 1024, 1024, smem, e);
    }
    __syncthreads();
    for (int i = 0; i < 32; ++i) ln_row(p, tok0 + w * 32 + i, lane);
  }
}
__global__ void __launch_bounds__(512) k_phase4(Params p) {
  extern __shared__ __attribute__((aligned(16))) char smem[];
  phase4(p, smem);
}

#define HY_US_BYTES 68608
#define HY_LDS (HY_US_BYTES + 65664)

__device__ __forceinline__ uint4 conv8(const u16* __restrict__ row, int tau, int t, int L, float cb, float w0, float w1, float w2) {
  uint4 raw = *(const uint4*)(row + tau);
  float v[10];
  v[0] = (t > 0) ? bf2f(row[tau - 1]) : 0.f;
  v[1] = bflo(raw.x); v[2] = bfhi(raw.x); v[3] = bflo(raw.y); v[4] = bfhi(raw.y);
  v[5] = bflo(raw.z); v[6] = bfhi(raw.z); v[7] = bflo(raw.w); v[8] = bfhi(raw.w);
  v[9] = (t + 8 < L) ? bf2f(row[tau + 8]) : 0.f;
  float o[8];
#pragma unroll
  for (int j = 0; j < 8; ++j) o[j] = cb + w0 * v[j] + w1 * v[j + 1] + w2 * v[j + 2];
  uint4 r; r.x = pack2(o[0], o[1]); r.y = pack2(o[2], o[3]); r.z = pack2(o[4], o[5]); r.w = pack2(o[6], o[7]);
  return r;
}

__device__ void hyena_unit(const Params& p, int order, bool samp, int c, char* smem) {
  const int tid = threadIdx.x, lane = tid & 63, w = tid >> 6;
  const int L = samp ? 16384 : 4096;
  const int LSH = samp ? 14 : 12;
  const int NB = samp ? 2 : 8;
  const int NISH = samp ? 4 : 2;
  const int P = 32 << NISH;
  const int LG = samp ? LG_S : LG_P;
  const int tokbase = samp ? 32768 : 0;
  u16* us = (u16*)smem;
  u16* grl = (u16*)(smem + HY_US_BYTES);
  const u16* UT = (const u16*)(p.ws + OFF_UT);
  const u16* GRg = (const u16*)((char*)p.out + (samp ? OFF_GRS : OFF_GRP)) + (long)(order * 512 + c) * LG;
  const u16* usrc = (order == 0) ? (UT + (long)c * NTOK + tokbase)
                                 : ((const u16*)((char*)p.out + OFF_Z1T) + (long)c * NTOK + tokbase);
  const int gch = 512 * (order + 1) + c;
  const u16* gsrc = UT + (long)gch * NTOK + tokbase;
  u16* dst = ((order == 0) ? (u16*)((char*)p.out + OFF_Z1T) : (u16*)(p.ws + OFF_Z2T)) + (long)c * NTOK + tokbase;

  __syncthreads();
  for (int i = tid; i < LG / 8; i += 512) *(uint4*)(grl + i * 8) = *(const uint4*)(GRg + i * 8);
  {
    const int pc = P >> 3;
    const uint4 z4 = make_uint4(0, 0, 0, 0);
    for (int i = tid; i < (NB + 1) * pc; i += 512) {
      int g = i / pc, r = i - g * pc;
      *(uint4*)(us + g * (L + P) + r * 8) = z4;
    }
  }
  if (order == 0) {
    const float cb = p.conv_b[c], w0 = p.conv_w[c], w1 = p.conv_w[1536 + c], w2 = p.conv_w[3072 + c];
    for (int i = tid; i < 4096; i += 512) {
      int tau = i * 8, b = tau >> LSH, t = tau & (L - 1);
      *(uint4*)(us + P + b * (L + P) + t) = conv8(usrc, tau, t, L, cb, w0, w1, w2);
    }
  } else {
    for (int i = tid; i < 4096; i += 512) {
      int tau = i * 8, b = tau >> LSH, t = tau & (L - 1);
      *(uint4*)(us + P + b * (L + P) + t) = *(const uint4*)(usrc + tau);
    }
  }
  __syncthreads();

  const int n = lane & 31, h = lane >> 5;
  const int bat = n >> NISH, ii = n & ((1 << NISH) - 1);
  const int ubase = P + bat * (L + P) + 32 * ii + 8 * h;
  const int ebase = L + 32 - n + 8 * h;
  const unsigned sh = (unsigned)(ebase & 1) * 16u;
  f32x16 acc0, acc1, acc2, acc3;
#pragma unroll
  for (int j = 0; j < 16; ++j) { acc0[j] = 0.f; acc1[j] = 0.f; acc2[j] = 0.f; acc3[j] = 0.f; }
  const int o0 = P * 4 * w;
  const int base_lo = o0 - (L - 16);
  const int base_hi = o0 + 3 * P + (P - 32);
  const int smin = -(P - 32), smax = L - 16;
  for (int base = base_lo; base <= base_hi; base += 16) {
    const int E = ebase - base;
    const unsigned* gp = (const unsigned*)grl + (E >> 1);
    unsigned d0 = gp[0], d1 = gp[1], d2 = gp[2], d3 = gp[3], d4 = gp[4];
    union { unsigned u[4]; bf16x8 v; } A;
    A.u[0] = __builtin_amdgcn_alignbit(d1, d0, sh);
    A.u[1] = __builtin_amdgcn_alignbit(d2, d1, sh);
    A.u[2] = __builtin_amdgcn_alignbit(d3, d2, sh);
    A.u[3] = __builtin_amdgcn_alignbit(d4, d3, sh);
    const int st0 = o0 - base;
    if (st0 >= smin && st0 <= smax)
      acc0 = __builtin_amdgcn_mfma_f32_32x32x16_bf16(A.v, *(const bf16x8*)(us + ubase + st0), acc0, 0, 0, 0);
    const int st1 = st0 + P;
    if (st1 >= smin && st1 <= smax)
      acc1 = __builtin_amdgcn_mfma_f32_32x32x16_bf16(A.v, *(const bf16x8*)(us + ubase + st1), acc1, 0, 0, 0);
    const int st2 = st1 + P;
    if (st2 >= smin && st2 <= smax)
      acc2 = __builtin_amdgcn_mfma_f32_32x32x16_bf16(A.v, *(const bf16x8*)(us + ubase + st2), acc2, 0, 0, 0);
    const int st3 = st2 + P;
    if (st3 >= smin && st3 <= smax)
      acc3 = __builtin_amdgcn_mfma_f32_32x32x16_bf16(A.v, *(const bf16x8*)(us + ubase + st3), acc3, 0, 0, 0);
  }
  __syncthreads();
  {
    const float cb = p.conv_b[gch], w0 = p.conv_w[gch], w1 = p.conv_w[1536 + gch], w2 = p.conv_w[3072 + gch];
    for (int i = tid; i < 4096; i += 512) {
      int tau = i * 8, t = tau & (L - 1);
      *(uint4*)(grl + tau) = conv8(gsrc, tau, t, L, cb, w0, w1, w2);
    }
  }
  __syncthreads();
  const float dv = p.hyd[order * 512 + c];
#define HY_EPI(ACC, R) do { \
    _Pragma("unroll") for (int g4 = 0; g4 < 4; ++g4) { \
      int t = o0 + P * (R) + 8 * g4 + 4 * h + 32 * ii; \
      int tau = (bat << LSH) + t; \
      uint2 uu = *(const uint2*)(us + P + bat * (L + P) + t); \
      uint2 gg = *(const uint2*)(grl + tau); \
      float y0 = bflo(gg.x) * (ACC[4 * g4 + 0] + dv * bflo(uu.x)); \
      float y1 = bfhi(gg.x) * (ACC[4 * g4 + 1] + dv * bfhi(uu.x)); \
      float y2 = bflo(gg.y) * (ACC[4 * g4 + 2] + dv * bflo(uu.y)); \
      float y3 = bfhi(gg.y) * (ACC[4 * g4 + 3] + dv * bfhi(uu.y)); \
      uint2 oo; oo.x = pack2(y0, y1); oo.y = pack2(y2, y3); \
      *(uint2*)(dst + tau) = oo; \
    } } while (0)
  HY_EPI(acc0, 0); HY_EPI(acc1, 1); HY_EPI(acc2, 2); HY_EPI(acc3, 3);
}

__device__ void hyena_phase(const Params& p, int order, char* smem) {
  for (int b = blockIdx.x; b < 256; b += gridDim.x) {
    hyena_unit(p, order, true, b, smem);
    hyena_unit(p, order, true, b + 256, smem);
    hyena_unit(p, order, false, b, smem);
    hyena_unit(p, order, false, b + 256, smem);
  }
}
__global__ void __launch_bounds__(512) k_hyena(Params p, int order) {
  extern __shared__ __attribute__((aligned(16))) char smem[];
  hyena_phase(p, order, smem);
}

#define VSTR 144
#define ATT_WAVE_LDS (32 * VSTR)
typedef short v4s __attribute__((ext_vector_type(4)));
typedef __attribute__((address_space(3))) v4s* lds_v4s_ptr;

__device__ __forceinline__ void attn_item(const Params& p, int item, char* vl, int lane) {
  int seqbase, L, head, r, ib;
  if (item < 8192) { int sq = item >> 10, rem = item & 1023; seqbase = sq * 4096; L = 4096; head = rem >> 7; r = (rem >> 3) & 15; ib = rem & 7; }
  else { int it2 = item - 8192; int sq = it2 >> 12, rem = it2 & 4095; seqbase = 32768 + sq * 16384; L = 16384; head = rem >> 9; r = (rem >> 5) & 15; ib = rem & 31; }
  const int n = lane & 31, h = lane >> 5;
  const int tmin = r + 512 * ib;
  const int tq = tmin + 16 * n;
  u16* Qb = (u16*)(p.ws + OFF_QB);
  const u16* Kb = (const u16*)(p.ws + OFF_KB) + head * 64;
  const u16* Vb = (const u16*)(p.ws + OFF_VB) + head * 64;
  u16* qrow = Qb + (long)(seqbase + tq) * 512 + head * 64;
  bf16x8 qf0 = *(const bf16x8*)(qrow + 8 * h), qf1 = *(const bf16x8*)(qrow + 16 + 8 * h),
         qf2 = *(const bf16x8*)(qrow + 32 + 8 * h), qf3 = *(const bf16x8*)(qrow + 48 + 8 * h);
  f32x16 o0, o1;
#pragma unroll
  for (int j = 0; j < 16; ++j) { o0[j] = 0.f; o1[j] = 0.f; }
  float m_run = -1e30f, l_run = 0.f;
  const float nslope = -exp2f(-(float)(head + 1)) * LOG2E;
  const int g = lane >> 4, i16 = lane & 15, tq4 = i16 >> 2, tp4 = i16 & 3;
  const int troff = (4 * (g >> 1) + tq4) * VSTR + (16 * (g & 1) + 4 * tp4) * 2;
  const int vkey0 = lane >> 3, vpart = lane & 7;

  for (int pat = 0; pat < 3; ++pat) {
    const int dil = (pat == 0) ? 1 : (pat == 1 ? 4 : 16);
    const int ntile = (pat == 0) ? 20 : (pat == 1 ? 8 : 5);
    const int kbase = tmin - 64 * dil;
    const float fd = (float)dil;
    const float dl0 = (float)(-64 * dil - 16 * n + 4 * h * dil);
    const float lo = fmaxf(-64.f * fd, -(float)tq);
    const float hi = fminf(64.f * fd, (float)(L - 1 - tq));
    for (int j = 0; j < ntile; ++j) {
      const int tk0 = kbase + 32 * j * dil;
      if (tk0 + 31 * dil < 0 || tk0 >= L) continue;
      int tk = tk0 + n * dil; tk = min(max(tk, 0), L - 1);
      const u16* krow = Kb + (long)(seqbase + tk) * 512 + 8 * h;
      bf16x8 kf0 = *(const bf16x8*)(krow), kf1 = *(const bf16x8*)(krow + 16), kf2 = *(const bf16x8*)(krow + 32), kf3 = *(const bf16x8*)(krow + 48);
#pragma unroll
      for (int it4 = 0; it4 < 4; ++it4) {
        int key = vkey0 + 8 * it4;
        int tv = tk0 + key * dil; tv = min(max(tv, 0), L - 1);
        uint4 vv = *(const uint4*)(Vb + (long)(seqbase + tv) * 512 + vpart * 8);
        *(uint4*)(vl + key * VSTR + vpart * 16) = vv;
      }
      f32x16 S;
#pragma unroll
      for (int jj = 0; jj < 16; ++jj) S[jj] = 0.f;
      S = __builtin_amdgcn_mfma_f32_32x32x16_bf16(kf0, qf0, S, 0, 0, 0);
      S = __builtin_amdgcn_mfma_f32_32x32x16_bf16(kf1, qf1, S, 0, 0, 0);
      S = __builtin_amdgcn_mfma_f32_32x32x16_bf16(kf2, qf2, S, 0, 0, 0);
      S = __builtin_amdgcn_mfma_f32_32x32x16_bf16(kf3, qf3, S, 0, 0, 0);
      const float dt = dl0 + (float)(32 * j * dil);
      float mx = -1e30f;
      bool valid[16];
#pragma unroll
      for (int jj = 0; jj < 16; ++jj) {
        float delta = dt + fd * (float)((jj & 3) + 8 * (jj >> 2));
        valid[jj] = (delta >= lo) && (delta <= hi);
        float sc = S[jj] + nslope * fabsf(delta);
        sc = valid[jj] ? sc : -1e30f;
        S[jj] = sc;
        mx = fmaxf(mx, sc);
      }
      mx = fmaxf(mx, __shfl_xor(mx, 32));
      const float m_new = fmaxf(m_run, mx);
      const float alpha = __builtin_amdgcn_exp2f(m_run - m_new);
      m_run = m_new;
      float psum = 0.f;
      float pv[16];
#pragma unroll
      for (int jj = 0; jj < 16; ++jj) {
        float pe = valid[jj] ? __builtin_amdgcn_exp2f(S[jj] - m_new) : 0.f;
        pv[jj] = pe; psum += pe;
      }
      l_run = l_run * alpha + psum;
#pragma unroll
      for (int jj = 0; jj < 16; ++jj) { o0[jj] *= alpha; o1[jj] *= alpha; }
      union { unsigned u[4]; bf16x8 v; } pf0, pf1;
#pragma unroll
      for (int q = 0; q < 4; ++q) { pf0.u[q] = pack2(pv[2 * q], pv[2 * q + 1]); pf1.u[q] = pack2(pv[8 + 2 * q], pv[8 + 2 * q + 1]); }
      __builtin_amdgcn_wave_barrier();
#define TRRD(s2, hh, dtt) __builtin_amdgcn_ds_read_tr16_b64_v4i16((lds_v4s_ptr)(vl + troff + (16 * (s2) + 8 * (hh)) * VSTR + 64 * (dtt)))
      {
        v4s a00 = TRRD(0, 0, 0), a01 = TRRD(0, 1, 0), b00 = TRRD(0, 0, 1), b01 = TRRD(0, 1, 1);
        v4s a10 = TRRD(1, 0, 0), a11 = TRRD(1, 1, 0), b10 = TRRD(1, 0, 1), b11 = TRRD(1, 1, 1);
        bf16x8 va0 = __builtin_shufflevector(a00, a01, 0, 1, 2, 3, 4, 5, 6, 7);
        bf16x8 vb0 = __builtin_shufflevector(b00, b01, 0, 1, 2, 3, 4, 5, 6, 7);
        bf16x8 va1 = __builtin_shufflevector(a10, a11, 0, 1, 2, 3, 4, 5, 6, 7);
        bf16x8 vb1 = __builtin_shufflevector(b10, b11, 0, 1, 2, 3, 4, 5, 6, 7);
        o0 = __builtin_amdgcn_mfma_f32_32x32x16_bf16(va0, pf0.v, o0, 0, 0, 0);
        o1 = __builtin_amdgcn_mfma_f32_32x32x16_bf16(vb0, pf0.v, o1, 0, 0, 0);
        o0 = __builtin_amdgcn_mfma_f32_32x32x16_bf16(va1, pf1.v, o0, 0, 0, 0);
        o1 = __builtin_amdgcn_mfma_f32_32x32x16_bf16(vb1, pf1.v, o1, 0, 0, 0);
      }
      __builtin_amdgcn_wave_barrier();
    }
  }
  const float ltot = l_run + __shfl_xor(l_run, 32);
  const float inv = 1.f / ltot;
#pragma unroll
  for (int g4 = 0; g4 < 4; ++g4) {
    uint2 w0, w1;
    w0.x = pack2(o0[4 * g4] * inv, o0[4 * g4 + 1] * inv); w0.y = pack2(o0[4 * g4 + 2] * inv, o0[4 * g4 + 3] * inv);
    w1.x = pack2(o1[4 * g4] * inv, o1[4 * g4 + 1] * inv); w1.y = pack2(o1[4 * g4 + 2] * inv, o1[4 * g4 + 3] * inv);
    *(uint2*)(qrow + 8 * g4 + 4 * h) = w0;
    *(uint2*)(qrow + 32 + 8 * g4 + 4 * h) = w1;
  }
}

__device__ void attn_phase(const Params& p, char* smem) {
  const int lane = threadIdx.x & 63, w = threadIdx.x >> 6;
  char* vl = smem + w * ATT_WAVE_LDS;
  __syncthreads();
  const int nwaves = gridDim.x * 8;
  const int per = (16384 + nwaves - 1) / nwaves;
  const int gw = blockIdx.x * 8 + w;
  for (int k = 0; k < per; ++k) {
    int item = gw * per + k;
    if (item < 16384) attn_item(p, item, vl, lane);
  }
}
#define ATTN_PHASE(p, smem) attn_phase(p, smem)

#ifndef ATTN_PHASE
#define ATTN_PHASE(p, smem) attn_naive_phase(p)
#endif

__global__ void __launch_bounds__(512) mega(Params p) {
  extern __shared__ __attribute__((aligned(16))) char smem[];
  cg::grid_group grid = cg::this_grid();
  phase0(p, smem);
  grid.sync();
  phase1(p, smem);
  grid.sync();
  hyena_phase(p, 0, smem);
  ATTN_PHASE(p, smem);
  grid.sync();
  convert_wout(p);
  hyena_phase(p, 1, smem);
  grid.sync();
  phase4(p, smem);
}

static Params make_params(void* const* d_in, void* d_out, void* d_ws) {
  Params p{};
  p.x0 = (const float*)d_in[0]; p.x1 = (const float*)d_in[1]; p.w_in = (const float*)d_in[2];
  p.conv_w = (const float*)d_in[3]; p.conv_b = (const float*)d_in[4];
  p.fw1 = (const float*)d_in[5]; p.fb1 = (const float*)d_in[6]; p.fw2 = (const float*)d_in[7]; p.fb2 = (const float*)d_in[8];
  p.fw3 = (const float*)d_in[9]; p.fb3 = (const float*)d_in[10]; p.ffreq = (const float*)d_in[11]; p.fw4 = (const float*)d_in[12];
  p.hyd = (const float*)d_in[13]; p.gna = (const float*)d_in[14]; p.gnh = (const float*)d_in[15];
  p.w_out = (const float*)d_in[16]; p.lng = (const float*)d_in[17]; p.lnb = (const float*)d_in[18];
  p.out = (float*)d_out; p.ws = (char*)d_ws;
  return p;
}

extern "C" void kernel_launch(void* const* d_in, const int* in_sizes, int n_in,
                              void* d_out, int out_size, void* d_ws, size_t ws_size,
                              hipStream_t stream) {
  Params p = make_params(d_in, d_out, d_ws);
  static int grid_blocks = 0;
  if (!grid_blocks) {
    (void)hipFuncSetAttribute((const void*)mega, hipFuncAttributeMaxDynamicSharedMemorySize, GEMM_LDS);
    int dev = 0, cus = 0, per_cu = 0;
    (void)hipGetDevice(&dev);
    (void)hipDeviceGetAttribute(&cus, hipDeviceAttributeMultiprocessorCount, dev);
    (void)hipOccupancyMaxActiveBlocksPerMultiprocessor(&per_cu, mega, 512, GEMM_LDS);
    if (per_cu < 1) per_cu = 1;
    grid_blocks = cus;
    if (grid_blocks > 256) grid_blocks = 256;
  }
  void* args[] = {&p};
  hipError_t e = hipLaunchCooperativeKernel((void*)mega, dim3(grid_blocks), dim3(512), args, GEMM_LDS, stream);
  if (e != hipSuccess) fprintf(stderr, "cooperative launch failed: %s (grid %d)\n", hipGetErrorString(e), grid_blocks);
}
```

```cpp
#include <hip/hip_runtime.h>
#include <hip/hip_cooperative_groups.h>
#include <cstdio>
namespace cg = cooperative_groups;

typedef unsigned short u16;
typedef short bf16x8 __attribute__((ext_vector_type(8)));
typedef short s16x4 __attribute__((ext_vector_type(4)));
typedef float f32x16 __attribute__((ext_vector_type(16)));

#define NTOK 65536
#define MiB (1024L * 1024L)
#define OFF_QB (0 * MiB)
#define OFF_KB (64 * MiB)
#define OFF_VB (128 * MiB)
#define OFF_GB (192 * MiB)
#define OFF_UT (320 * MiB)
#define OFF_MIXED (64 * MiB)
#define OFF_WBOUT (384 * MiB)
#define OFF_Z2T (320 * MiB)
#define OFF_XB (0 * MiB)
#define OFF_Z1T (0 * MiB)
#define OFF_Z0T (64 * MiB)
#define LG_S 32832
#define LG_P 8256
#define OFF_GRS (128 * MiB)
#define OFF_GRP (128 * MiB + 1024L * LG_S * 2)
#define OFF_WBIN (212 * MiB)

struct Params {
  const float *x0, *x1, *w_in, *conv_w, *conv_b, *fw1, *fb1, *fw2, *fb2, *fw3, *fb3, *ffreq, *fw4, *hyd, *gna, *gnh, *w_out, *lng, *lnb;
  float* out;
  char* ws;
};

__device__ __forceinline__ u16 f2bf(float f) {
  unsigned u = __float_as_uint(f);
  u += 0x7fffu + ((u >> 16) & 1u);
  return (u16)(u >> 16);
}
__device__ __forceinline__ float bf2f(u16 b) { return __uint_as_float(((unsigned)b) << 16); }
__device__ __forceinline__ unsigned pack2(float a, float b) { return (unsigned)f2bf(a) | ((unsigned)f2bf(b) << 16); }
__device__ __forceinline__ float bflo(unsigned u) { return __uint_as_float(u << 16); }
__device__ __forceinline__ float bfhi(unsigned u) { return __uint_as_float(u & 0xffff0000u); }
__device__ __forceinline__ float silu_f(float x) { return x / (1.f + __expf(-x)); }

__device__ __forceinline__ void tok_info(int tok, int& t, int& L, int& seqbase) {
  if (tok < 32768) { L = 4096; t = tok & 4095; seqbase = tok & ~4095; }
  else { L = 16384; t = tok & 16383; seqbase = tok & ~16383; }
}

__device__ void filter_item(const Params& p, int item, char* smem) {
  const int tid = threadIdx.x;
  const bool samp = item < 1024;
  const int L = samp ? 16384 : 4096;
  const int LG = samp ? LG_S : LG_P;
  const int it2 = samp ? item : item - 1024;
  const int q = it2 & 3;
  const int l0 = (it2 >> 2) * 64;
  const int n = q >> 1, dir = q & 1;
  const int lagbase = l0 + (dir == 0 ? 1 : 0);
  u16* GR = (u16*)((char*)p.out + (samp ? OFF_GRS : OFF_GRP));
  float* zs = (float*)smem;
  float* ha = zs + 64 * 36;
  float* hb = ha + 64 * 64;
  __syncthreads();
  for (int i = tid; i < 64 * 33; i += 512) {
    int l = i / 33, f = i - l * 33;
    int lag = lagbase + l;
    float t = (float)lag / (float)(L - 1);
    float w = (float)lag / (float)L;
    float v;
    if (f == 0) v = t;
    else {
      int j = (f - 1) & 15;
      float fr = 1e-4f + (float)j * ((15.0f - 1e-4f) / 15.0f);
      float a = fr * w;
      v = (f <= 16) ? __builtin_amdgcn_cosf(a) : -__builtin_amdgcn_sinf(a);
    }
    zs[l * 36 + f] = v;
  }
  __syncthreads();
#pragma unroll 1
  for (int qq = 0; qq < 8; ++qq) {
    int o = tid + 512 * qq; int l = o >> 6, u = o & 63;
    float acc = p.fb1[u];
#pragma unroll 3
    for (int f = 0; f < 33; ++f) acc += zs[l * 36 + f] * p.fw1[f * 64 + u];
    ha[l * 64 + u] = __sinf(p.ffreq[u] * acc);
  }
  __syncthreads();
#pragma unroll 1
  for (int qq = 0; qq < 8; ++qq) {
    int o = tid + 512 * qq; int l = o >> 6, u = o & 63;
    float acc = p.fb2[u];
#pragma unroll 4
    for (int f = 0; f < 64; ++f) acc += ha[l * 64 + f] * p.fw2[f * 64 + u];
    hb[l * 64 + u] = __sinf(p.ffreq[64 + u] * acc);
  }
  __syncthreads();
#pragma unroll 1
  for (int qq = 0; qq < 8; ++qq) {
    int o = tid + 512 * qq; int l = o >> 6, u = o & 63;
    float acc = p.fb3[u];
#pragma unroll 4
    for (int f = 0; f < 64; ++f) acc += hb[l * 64 + f] * p.fw3[f * 64 + u];
    ha[u * 64 + l] = __sinf(p.ffreq[128 + u] * acc);
  }
  __syncthreads();
  const int c = tid;
  const float min_decay = -3.0701134573253943f;
  const float max_decay = -15.350567286626972f;
  const float delta = fabsf(min_decay + (max_decay - min_decay) * ((float)c / 511.0f));
  float acc[64];
#pragma unroll
  for (int l = 0; l < 64; ++l) acc[l] = 0.f;
  float a0 = 0.f;
  const bool need0 = (dir == 1) && (l0 == 0);
#pragma unroll 1
  for (int j = 0; j < 64; ++j) {
    const float wv = p.fw4[j * 2048 + q * 512 + c];
    const float4* hr = (const float4*)(ha + j * 64);
#pragma unroll
    for (int l4 = 0; l4 < 16; ++l4) {
      float4 hv = hr[l4];
      acc[4 * l4 + 0] += hv.x * wv; acc[4 * l4 + 1] += hv.y * wv; acc[4 * l4 + 2] += hv.z * wv; acc[4 * l4 + 3] += hv.w * wv;
    }
    if (need0) a0 += ha[j * 64] * p.fw4[j * 2048 + (q - 1) * 512 + c];
  }
  if (need0) acc[0] = a0;
  const float tinv = 1.f / (float)(L - 1);
#pragma unroll
  for (int l = 0; l < 64; ++l) {
    int lag = lagbase + l;
    float v = acc[l] * expf(-(float)lag * tinv * delta);
    acc[l] = (lag >= L) ? 0.f : v;
  }
  u16* row = GR + (long)(n * 512 + c) * LG;
  if (dir == 1) {
    u16* dst = row + (L + 32 + l0);
#pragma unroll
    for (int e = 0; e < 8; ++e) {
      uint4 o;
      o.x = pack2(acc[8 * e + 0], acc[8 * e + 1]); o.y = pack2(acc[8 * e + 2], acc[8 * e + 3]);
      o.z = pack2(acc[8 * e + 4], acc[8 * e + 5]); o.w = pack2(acc[8 * e + 6], acc[8 * e + 7]);
      *(uint4*)(dst + 8 * e) = o;
    }
  } else {
    u16* dst = row + (L + 32 - l0 - 64);
#pragma unroll
    for (int e = 0; e < 8; ++e) {
      uint4 o;
      o.x = pack2(acc[63 - 8 * e], acc[62 - 8 * e]); o.y = pack2(acc[61 - 8 * e], acc[60 - 8 * e]);
      o.z = pack2(acc[59 - 8 * e], acc[58 - 8 * e]); o.w = pack2(acc[57 - 8 * e], acc[56 - 8 * e]);
      *(uint4*)(dst + 8 * e) = o;
    }
    if (l0 == 0) {
      const uint4 z4 = make_uint4(0, 0, 0, 0);
#pragma unroll
      for (int e = 0; e < 4; ++e) { *(uint4*)(row + 8 * e) = z4; *(uint4*)(row + 2 * L + 32 + 8 * e) = z4; }
    }
  }
}

__device__ void phase0(const Params& p, char* smem) {
  const int tid = threadIdx.x, bid = blockIdx.x, nb = gridDim.x;
  u16* xb = (u16*)((char*)p.out + OFF_XB);
  const long nchunk = (long)NTOK * 1024 / 8;
  for (long cidx = (long)bid * 512 + tid; cidx < nchunk; cidx += (long)nb * 512) {
    long e = cidx * 8;
    const float* src = (e < 32768L * 1024) ? (p.x0 + e) : (p.x1 + (e - 32768L * 1024));
    float4 a = *(const float4*)src, b = *(const float4*)(src + 4);
    uint4 o;
    o.x = pack2(a.x, a.y); o.y = pack2(a.z, a.w); o.z = pack2(b.x, b.y); o.w = pack2(b.z, b.w);
    *(uint4*)(xb + e) = o;
  }
  u16* wbin = (u16*)((char*)p.out + OFF_WBIN);
  for (int id = bid * 512 + tid; id < 4096 * 128; id += nb * 512) {
    int n = id & 4095, kc = id >> 12;
    float v[8];
#pragma unroll
    for (int j = 0; j < 8; ++j) v[j] = p.w_in[(long)(kc * 8 + j) * 4096 + n];
    uint4 o;
    o.x = pack2(v[0], v[1]); o.y = pack2(v[2], v[3]); o.z = pack2(v[4], v[5]); o.w = pack2(v[6], v[7]);
    *(uint4*)(wbin + (long)n * 1024 + kc * 8) = o;
  }
  for (int item = bid; item < 1280; item += nb) filter_item(p, item, smem);
}

__device__ void convert_wout(const Params& p) {
  const int tid = threadIdx.x, bid = blockIdx.x, nb = gridDim.x;
  u16* wb = (u16*)(p.ws + OFF_WBOUT);
  for (int id = bid * 512 + tid; id < 1024 * 128; id += nb * 512) {
    int n = id & 1023, kc = id >> 10;
    float v[8];
#pragma unroll
    for (int j = 0; j < 8; ++j) v[j] = p.w_out[(long)(kc * 8 + j) * 1024 + n];
    uint4 o;
    o.x = pack2(v[0], v[1]); o.y = pack2(v[2], v[3]); o.z = pack2(v[4], v[5]); o.w = pack2(v[6], v[7]);
    *(uint4*)(wb + (long)n * 1024 + kc * 8) = o;
  }
}

#define QSCALE 0.18033688011112042f
#define LOG2E 1.4426950408889634f

__device__ __forceinline__ void inproj_store1(const Params& p, int tok, int col, float v) {
  u16* ws16 = (u16*)p.ws;
  if (col < 512) ws16[(OFF_QB >> 1) + (long)tok * 512 + col] = f2bf(v * QSCALE);
  else if (col < 1024) ws16[(OFF_KB >> 1) + (long)tok * 512 + (col - 512)] = f2bf(v);
  else if (col < 1536) ws16[(OFF_VB >> 1) + (long)tok * 512 + (col - 1024)] = f2bf(v);
  else if (col < 2048) ws16[(OFF_GB >> 1) + (long)tok * 1024 + (col - 1536)] = f2bf(silu_f(v));
  else if (col < 3584) ws16[(OFF_UT >> 1) + (long)(col - 2048) * NTOK + tok] = f2bf(v);
  else ws16[(OFF_GB >> 1) + (long)tok * 1024 + 512 + (col - 3584)] = f2bf(silu_f(v));
}

__device__ __forceinline__ float shortconv_at(const Params& p, int ch, int tok) {
  const u16* row = (const u16*)(p.ws + OFF_UT) + (long)ch * NTOK;
  int t, L, sb; tok_info(tok, t, L, sb);
  float a = (t > 0) ? bf2f(row[tok - 1]) : 0.f;
  float b = bf2f(row[tok]);
  float c = (t < L - 1) ? bf2f(row[tok + 1]) : 0.f;
  return p.conv_b[ch] + p.conv_w[ch] * a + p.conv_w[1536 + ch] * b + p.conv_w[3072 + ch] * c;
}

__global__ void __launch_bounds__(512) k_phase0(Params p) {
  extern __shared__ __attribute__((aligned(16))) char smem[];
  phase0(p, smem);
}
__global__ void __launch_bounds__(512) k_convert_wout(Params p) { convert_wout(p); }

__global__ void __launch_bounds__(256) n_inproj(Params p) {
  long gid = (long)blockIdx.x * 256 + threadIdx.x;
  int col = (int)(gid & 4095), tok = (int)(gid >> 12);
  const u16* xb = (const u16*)((char*)p.out + OFF_XB) + (long)tok * 1024;
  const u16* wb = (const u16*)((char*)p.out + OFF_WBIN) + (long)col * 1024;
  float acc = 0.f;
  for (int k = 0; k < 1024; k += 8) {
    uint4 a = *(const uint4*)(xb + k), b = *(const uint4*)(wb + k);
    acc += bflo(a.x) * bflo(b.x) + bfhi(a.x) * bfhi(b.x) + bflo(a.y) * bflo(b.y) + bfhi(a.y) * bfhi(b.y)
         + bflo(a.z) * bflo(b.z) + bfhi(a.z) * bfhi(b.z) + bflo(a.w) * bflo(b.w) + bfhi(a.w) * bfhi(b.w);
  }
  inproj_store1(p, tok, col, acc);
}

__global__ void __launch_bounds__(256) n_attn(Params p) {
  int gid = blockIdx.x * 256 + threadIdx.x;
  int tok = gid & 65535, head = gid >> 16;
  int t, L, sb; tok_info(tok, t, L, sb);
  u16* Qb = (u16*)(p.ws + OFF_QB);
  const u16* Kb = (const u16*)(p.ws + OFF_KB);
  const u16* Vb = (const u16*)(p.ws + OFF_VB);
  float q[64], o[64];
#pragma unroll
  for (int d = 0; d < 64; ++d) { q[d] = bf2f(Qb[(long)tok * 512 + head * 64 + d]); o[d] = 0.f; }
  float m = -1e30f, l = 0.f;
  const float slope2 = exp2f(-(float)(head + 1)) * LOG2E;
  for (int pat = 0; pat < 3; ++pat) {
    int dil = (pat == 0) ? 1 : (pat == 1 ? 4 : 16);
    for (int j = -64; j <= 64; ++j) {
      int tk = t + j * dil;
      if (tk < 0 || tk >= L) continue;
      const u16* kr = Kb + (long)(sb + tk) * 512 + head * 64;
      const u16* vr = Vb + (long)(sb + tk) * 512 + head * 64;
      float s = 0.f;
#pragma unroll
      for (int d = 0; d < 64; ++d) s += q[d] * bf2f(kr[d]);
      s -= slope2 * (float)(abs(j) * dil);
      if (s > m) {
        float sc = exp2f(m - s);
        l *= sc;
#pragma unroll
        for (int d = 0; d < 64; ++d) o[d] *= sc;
        m = s;
      }
      float pr = exp2f(s - m);
      l += pr;
#pragma unroll
      for (int d = 0; d < 64; ++d) o[d] += pr * bf2f(vr[d]);
    }
  }
  float inv = 1.f / l;
#pragma unroll
  for (int d = 0; d < 64; ++d) Qb[(long)tok * 512 + head * 64 + d] = f2bf(o[d] * inv);
}

__global__ void __launch_bounds__(256) n_z0(Params p) {
  int gid = blockIdx.x * 256 + threadIdx.x;
  int tok = gid & 65535, c = gid >> 16;
  u16* z0 = (u16*)((char*)p.out + OFF_Z0T);
  z0[(long)c * NTOK + tok] = f2bf(shortconv_at(p, c, tok));
}

__global__ void __launch_bounds__(256) n_conv(Params p, int order) {
  int gid = blockIdx.x * 256 + threadIdx.x;
  int tok = gid & 65535, c = gid >> 16;
  int t, L, sb; tok_info(tok, t, L, sb);
  const bool samp = tok >= 32768;
  const u16* src = (order == 0) ? (const u16*)((char*)p.out + OFF_Z0T) : (const u16*)((char*)p.out + OFF_Z1T);
  const u16* urow = src + (long)c * NTOK + sb;
  const u16* gr = (const u16*)((char*)p.out + (samp ? OFF_GRS : OFF_GRP)) + (long)(order * 512 + c) * (samp ? LG_S : LG_P);
  const u16* g0 = gr + (L + 32 - t);
  float y = 0.f;
  for (int s = 0; s < L; ++s) y += bf2f(g0[s]) * bf2f(urow[s]);
  float gate = shortconv_at(p, 512 * (order + 1) + c, tok);
  float dv = p.hyd[order * 512 + c];
  float r = gate * (y + dv * bf2f(urow[t]));
  u16* dst = (order == 0) ? (u16*)((char*)p.out + OFF_Z1T) : (u16*)(p.ws + OFF_Z2T);
  dst[(long)c * NTOK + tok] = f2bf(r);
}

__global__ void __launch_bounds__(256) n_outproj(Params p) {
  long gid = (long)blockIdx.x * 256 + threadIdx.x;
  int col = (int)(gid & 1023), tok = (int)(gid >> 10);
  const u16* a = (const u16*)(p.ws + OFF_MIXED) + (long)tok * 1024;
  const u16* wb = (const u16*)(p.ws + OFF_WBOUT) + (long)col * 1024;
  float acc = 0.f;
  for (int k = 0; k < 1024; k += 8) {
    uint4 x = *(const uint4*)(a + k), b = *(const uint4*)(wb + k);
    acc += bflo(x.x) * bflo(b.x) + bfhi(x.x) * bfhi(b.x) + bflo(x.y) * bflo(b.y) + bfhi(x.y) * bfhi(b.y)
         + bflo(x.z) * bflo(b.z) + bfhi(x.z) * bfhi(b.z) + bflo(x.w) * bflo(b.w) + bfhi(x.w) * bfhi(b.w);
  }
  const float* xr = (tok < 32768) ? (p.x0 + (long)tok * 1024) : (p.x1 + (long)(tok - 32768) * 1024);
  p.out[(long)tok * 1024 + col] = 1.189207115002721f * xr[col] + acc;
}

__device__ __forceinline__ float wave_sum(float v) {
#pragma unroll
  for (int o = 32; o; o >>= 1) v += __shfl_xor(v, o);
  return v;
}

__device__ __forceinline__ void mixed_row(const Params& p, int tok, int lane) {
  u16* mixed = (u16*)(p.ws + OFF_MIXED) + (long)tok * 1024;
  const u16* Gb = (const u16*)(p.ws + OFF_GB) + (long)tok * 1024;
  {
    uint4 a = *(const uint4*)((const u16*)(p.ws + OFF_QB) + (long)tok * 512 + lane * 8);
    float v[8] = {bflo(a.x), bfhi(a.x), bflo(a.y), bfhi(a.y), bflo(a.z), bfhi(a.z), bflo(a.w), bfhi(a.w)};
    float ssq = 0.f;
#pragma unroll
    for (int j = 0; j < 8; ++j) ssq += v[j] * v[j];
    ssq = wave_sum(ssq);
    float r = rsqrtf(ssq * (1.f / 512.f) + 1e-6f);
    uint4 g = *(const uint4*)(Gb + lane * 8);
    float sg[8] = {bflo(g.x), bfhi(g.x), bflo(g.y), bfhi(g.y), bflo(g.z), bfhi(g.z), bflo(g.w), bfhi(g.w)};
    float4 n0 = *(const float4*)(p.gna + lane * 8), n1 = *(const float4*)(p.gna + lane * 8 + 4);
    float gn[8] = {n0.x, n0.y, n0.z, n0.w, n1.x, n1.y, n1.z, n1.w};
    float o[8];
#pragma unroll
    for (int j = 0; j < 8; ++j) o[j] = v[j] * r * gn[j] * sg[j];
    uint4 w; w.x = pack2(o[0], o[1]); w.y = pack2(o[2], o[3]); w.z = pack2(o[4], o[5]); w.w = pack2(o[6], o[7]);
    *(uint4*)(mixed + lane * 8) = w;
  }
}

#define ZSTR 272
__device__ void mixed_hyena_128(const Params& p, int tok0, char* smem) {
  const int tid = threadIdx.x;
  const u16* z2 = (const u16*)(p.ws + OFF_Z2T);
  float* ssq = (float*)(smem + 512 * ZSTR);
  __syncthreads();
#pragma unroll 4
  for (int it = 0; it < 16; ++it) {
    int id = it * 512 + tid; int row = id >> 4, part = id & 15;
    *(uint4*)(smem + row * ZSTR + part * 16) = *(const uint4*)(z2 + (long)row * NTOK + tok0 + part * 8);
  }
  __syncthreads();
  const int tk = tid & 127, cg = tid >> 7;
  const char* zc = smem + (cg * 128) * ZSTR + tk * 2;
  float acc = 0.f;
#pragma unroll 8
  for (int c = 0; c < 128; ++c) { float v = bf2f(*(const u16*)(zc + c * ZSTR)); acc += v * v; }
  ssq[cg * 128 + tk] = acc;
  __syncthreads();
  const float tot = ssq[tk] + ssq[128 + tk] + ssq[256 + tk] + ssq[384 + tk];
  const float r = rsqrtf(tot * (1.f / 512.f) + 1e-6f);
  const int tok = tok0 + tk;
  const u16* Gb = (const u16*)(p.ws + OFF_GB) + (long)tok * 1024 + 512 + cg * 128;
  u16* mixed = (u16*)(p.ws + OFF_MIXED) + (long)tok * 1024 + 512 + cg * 128;
  const float* gn = p.gnh + cg * 128;
#pragma unroll 2
  for (int i = 0; i < 16; ++i) {
    uint4 g = *(const uint4*)(Gb + i * 8);
    float sg[8] = {bflo(g.x), bfhi(g.x), bflo(g.y), bfhi(g.y), bflo(g.z), bfhi(g.z), bflo(g.w), bfhi(g.w)};
    float o[8];
#pragma unroll
    for (int j = 0; j < 8; ++j) o[j] = bf2f(*(const u16*)(zc + (i * 8 + j) * ZSTR)) * r * gn[i * 8 + j] * sg[j];
    uint4 wv; wv.x = pack2(o[0], o[1]); wv.y = pack2(o[2], o[3]); wv.z = pack2(o[4], o[5]); wv.w = pack2(o[6], o[7]);
    *(uint4*)(mixed + i * 8) = wv;
  }
}

__device__ __forceinline__ void ln_row(const Params& p, int tok, int lane) {
  float* row = p.out + (long)tok * 1024;
  float4 v[4];
  float s = 0.f;
#pragma unroll
  for (int q = 0; q < 4; ++q) { v[q] = *(const float4*)(row + q * 256 + lane * 4); s += v[q].x + v[q].y + v[q].z + v[q].w; }
  s = wave_sum(s);
  float mu = s * (1.f / 1024.f);
  float ss = 0.f;
#pragma unroll
  for (int q = 0; q < 4; ++q) {
    float a = v[q].x - mu, b = v[q].y - mu, c = v[q].z - mu, d = v[q].w - mu;
    ss += a * a + b * b + c * c + d * d;
  }
  ss = wave_sum(ss);
  float rstd = rsqrtf(ss * (1.f / 1024.f) + 1e-5f);
#pragma unroll
  for (int q = 0; q < 4; ++q) {
    float4 g = *(const float4*)(p.lng + q * 256 + lane * 4), b = *(const float4*)(p.lnb + q * 256 + lane * 4);
    float4 o;
    o.x = (v[q].x - mu) * rstd * g.x + b.x; o.y = (v[q].y - mu) * rstd * g.y + b.y;
    o.z = (v[q].z - mu) * rstd * g.z + b.z; o.w = (v[q].w - mu) * rstd * g.w + b.w;
    *(float4*)(row + q * 256 + lane * 4) = o;
  }
}

__global__ void __launch_bounds__(512) k_ln(Params p) {
  int tok = blockIdx.x * 8 + (threadIdx.x >> 6);
  ln_row(p, tok, threadIdx.x & 63);
}

#define LDSROW 144
#define TILEB (256 * LDSROW)
#define GEMM_LDS (4 * TILEB)

template <class Epi>
__device__ __forceinline__ void gemm_tile(const u16* __restrict__ A, long lda, const u16* __restrict__ B, long ldb,
                                          int K, char* smem, Epi& epi) {
  const int tid = threadIdx.x, lane = tid & 63, w = tid >> 6, wm = w >> 2, wn = w & 3;
  const int l31 = lane & 31, h = lane >> 5;
  f32x16 acc[4][2];
#pragma unroll
  for (int mi = 0; mi < 4; ++mi)
#pragma unroll
    for (int ni = 0; ni < 2; ++ni)
#pragma unroll
      for (int j = 0; j < 16; ++j) acc[mi][ni][j] = 0.f;
  uint4 ra0, ra1, ra2, ra3, rb0, rb1, rb2, rb3;
  const int srow = tid >> 3, skc = tid & 7;
  const u16* Ag = A + (long)srow * lda + skc * 8;
  const u16* Bg = B + (long)srow * ldb + skc * 8;
  const int soff = srow * LDSROW + skc * 16;
  const int nk = K >> 6;
#define GLD(kk) do { \
    ra0 = *(const uint4*)(Ag + (kk)); ra1 = *(const uint4*)(Ag + 64 * lda + (kk)); ra2 = *(const uint4*)(Ag + 128 * lda + (kk)); ra3 = *(const uint4*)(Ag + 192 * lda + (kk)); \
    rb0 = *(const uint4*)(Bg + (kk)); rb1 = *(const uint4*)(Bg + 64 * ldb + (kk)); rb2 = *(const uint4*)(Bg + 128 * ldb + (kk)); rb3 = *(const uint4*)(Bg + 192 * ldb + (kk)); } while (0)
#define SST(d) do { \
    *(uint4*)((d) + soff) = ra0; *(uint4*)((d) + soff + 64 * LDSROW) = ra1; *(uint4*)((d) + soff + 128 * LDSROW) = ra2; *(uint4*)((d) + soff + 192 * LDSROW) = ra3; \
    *(uint4*)((d) + TILEB + soff) = rb0; *(uint4*)((d) + TILEB + soff + 64 * LDSROW) = rb1; *(uint4*)((d) + TILEB + soff + 128 * LDSROW) = rb2; *(uint4*)((d) + TILEB + soff + 192 * LDSROW) = rb3; } while (0)
  GLD(0);
  __syncthreads();
  SST(smem);
  __syncthreads();
  for (int kt = 0; kt < nk; ++kt) {
    if (kt + 1 < nk) GLD((kt + 1) * 64);
    const char* a = smem + (kt & 1) * 2 * TILEB;
    const char* b = a + TILEB;
#pragma unroll 2
    for (int ks = 0; ks < 4; ++ks) {
      bf16x8 af[4], bfr[2];
#pragma unroll
      for (int mi = 0; mi < 4; ++mi) af[mi] = *(const bf16x8*)(a + (wm * 128 + mi * 32 + l31) * LDSROW + ks * 32 + h * 16);
#pragma unroll
      for (int ni = 0; ni < 2; ++ni) bfr[ni] = *(const bf16x8*)(b + (wn * 64 + ni * 32 + l31) * LDSROW + ks * 32 + h * 16);
#pragma unroll
      for (int mi = 0; mi < 4; ++mi)
#pragma unroll
        for (int ni = 0; ni < 2; ++ni)
          acc[mi][ni] = __builtin_amdgcn_mfma_f32_32x32x16_bf16(af[mi], bfr[ni], acc[mi][ni], 0, 0, 0);
    }
    if (kt + 1 < nk) {
      char* d = smem + ((kt + 1) & 1) * 2 * TILEB;
      SST(d);
    }
    __syncthreads();
  }
#pragma unroll
  for (int mi = 0; mi < 4; ++mi)
#pragma unroll
    for (int ni = 0; ni < 2; ++ni)
#pragma unroll
      for (int g = 0; g < 4; ++g)
        epi(wm * 128 + mi * 32 + 8 * g + 4 * h, wn * 64 + ni * 32 + l31,
            acc[mi][ni][4 * g], acc[mi][ni][4 * g + 1], acc[mi][ni][4 * g + 2], acc[mi][ni][4 * g + 3]);
}

struct EpiTokMajor {
  char* ws; int nt; int tok0;
  __device__ __forceinline__ void operator()(int m, int n, float v0, float v1, float v2, float v3) const {
    int tok = tok0 + n;
    int col = nt * 256 + m;
    u16* dst;
    if (col < 512) { dst = (u16*)(ws + OFF_QB) + (long)tok * 512 + col; v0 *= QSCALE; v1 *= QSCALE; v2 *= QSCALE; v3 *= QSCALE; }
    else if (col < 1024) dst = (u16*)(ws + OFF_KB) + (long)tok * 512 + (col - 512);
    else if (col < 1536) dst = (u16*)(ws + OFF_VB) + (long)tok * 512 + (col - 1024);
    else {
      int gc = (col < 2048) ? (col - 1536) : (512 + col - 3584);
      dst = (u16*)(ws + OFF_GB) + (long)tok * 1024 + gc;
      v0 = silu_f(v0); v1 = silu_f(v1); v2 = silu_f(v2); v3 = silu_f(v3);
    }
    uint2 o; o.x = pack2(v0, v1); o.y = pack2(v2, v3);
    *(uint2*)dst = o;
  }
};
struct EpiChanMajor {
  char* ws; int ch0; int tok0;
  __device__ __forceinline__ void operator()(int m, int n, float v0, float v1, float v2, float v3) const {
    u16* dst = (u16*)(ws + OFF_UT) + (long)(ch0 + n) * NTOK + tok0 + m;
    uint2 o; o.x = pack2(v0, v1); o.y = pack2(v2, v3);
    *(uint2*)dst = o;
  }
};

__device__ void phase1(const Params& p, char* smem) {
  const u16* xb = (const u16*)((char*)p.out + OFF_XB);
  const u16* wb = (const u16*)((char*)p.out + OFF_WBIN);
  for (int mt = blockIdx.x; mt < 256; mt += gridDim.x) {
    const int tok0 = mt * 256;
    for (int nt = 0; nt < 16; ++nt) {
      if (nt >= 8 && nt < 14) {
        EpiChanMajor e{p.ws, (nt - 8) * 256, tok0};
        gemm_tile(xb + (long)tok0 * 1024, 1024, wb + (long)nt * 256 * 1024, 1024, 1024, smem, e);
      } else {
        EpiTokMajor e{p.ws, nt, tok0};
        gemm_tile(wb + (long)nt * 256 * 1024, 1024, xb + (long)tok0 * 1024, 1024, 1024, smem, e);
      }
    }
  }
}
__global__ void __launch_bounds__(512) k_phase1(Params p) {
  extern __shared__ __attribute__((aligned(16))) char smem[];
  phase1(p, smem);
}

struct EpiOut {
  const float* x0; const float* x1; float* out; int ct; int tok0;
  __device__ __forceinline__ void operator()(int m, int n, float v0, float v1, float v2, float v3) const {
    int tok = tok0 + n, col = ct * 256 + m;
    const float* xr = (tok < 32768) ? (x0 + (long)tok * 1024) : (x1 + (long)(tok - 32768) * 1024);
    float4 xv = *(const float4*)(xr + col);
    const float alpha = 1.189207115002721f;
    float4 o; o.x = alpha * xv.x + v0; o.y = alpha * xv.y + v1; o.z = alpha * xv.z + v2; o.w = alpha * xv.w + v3;
    *(float4*)(out + (long)tok * 1024 + col) = o;
  }
};

__device__ void phase4(const Params& p, char* smem) {
  const u16* mixed = (const u16*)(p.ws + OFF_MIXED);
  const u16* wb = (const u16*)(p.ws + OFF_WBOUT);
  const int lane = threadIdx.x & 63, w = threadIdx.x >> 6;
  for (int mt = blockIdx.x; mt < 256; mt += gridDim.x) {
    const int tok0 = mt * 256;
    mixed_hyena_128(p, tok0, smem);
    mixed_hyena_128(p, tok0 + 128, smem);
    for (int i = 0; i < 32; ++i) mixed_row(p, tok0 + w * 32 + i, lane);
    __syncthreads();
    for (int ct = 0; ct < 4; ++ct) {
      EpiOut e{p.x0, p.x1, p.out, ct, tok0};
      gemm_tile(wb + (long)ct * 256 * 1024, 1024, mixed + (long)tok0 * 1024, 1024, 1024, smem, e);
    }
    __syncthreads();
    for (int i = 0; i < 32; ++i) ln_row(p, tok0 + w * 32 + i, lane);
  }
}
__global__ void __launch_bounds__(512) k_phase4(Params p) {
  extern __shared__ __attribute__((aligned(16))) char smem[];
  phase4(p, smem);
}

#define HY_US_BYTES 85760
#define HY_ZOFF 85760
#define HY_ZBYTES 5248
#define HY_GRL_OFF (HY_ZOFF + HY_ZBYTES)
#define HY_LDS (HY_GRL_OFF + 65664)
#define PHYS(x) ((x) + (((x) >> 5) << 3))

__device__ __forceinline__ uint4 conv8(const u16* __restrict__ row, int tau, int t, int L, float cb, float w0, float w1, float w2) {
  uint4 raw = *(const uint4*)(row + tau);
  float v[10];
  v[0] = (t > 0) ? bf2f(row[tau - 1]) : 0.f;
  v[1] = bflo(raw.x); v[2] = bfhi(raw.x); v[3] = bflo(raw.y); v[4] = bfhi(raw.y);
  v[5] = bflo(raw.z); v[6] = bfhi(raw.z); v[7] = bflo(raw.w); v[8] = bfhi(raw.w);
  v[9] = (t + 8 < L) ? bf2f(row[tau + 8]) : 0.f;
  float o[8];
#pragma unroll
  for (int j = 0; j < 8; ++j) o[j] = cb + w0 * v[j] + w1 * v[j + 1] + w2 * v[j + 2];
  uint4 r; r.x = pack2(o[0], o[1]); r.y = pack2(o[2], o[3]); r.z = pack2(o[4], o[5]); r.w = pack2(o[6], o[7]);
  return r;
}

template <bool SAMP>
__device__ __forceinline__ void hyena_unit(const Params& p, int order, int c, char* smem) {
  constexpr int L = SAMP ? 16384 : 4096;
  constexpr int LSH = SAMP ? 14 : 12;
  constexpr int NB = SAMP ? 2 : 8;
  constexpr int P = SAMP ? 512 : 128;
  constexpr int LG = SAMP ? LG_S : LG_P;
  constexpr int BS = L + P;
  constexpr int TB = P * 5 / 2;
  constexpr int tokbase = SAMP ? 32768 : 0;
  const int tid = threadIdx.x, lane = tid & 63;
  const int w = __builtin_amdgcn_readfirstlane(tid >> 6);
  u16* us = (u16*)smem;
  u16* grl = (u16*)(smem + HY_GRL_OFF);
  const u16* UT = (const u16*)(p.ws + OFF_UT);
  const u16* GRg = (const u16*)((char*)p.out + (SAMP ? OFF_GRS : OFF_GRP)) + (long)(order * 512 + c) * LG;
  const u16* usrc = (order == 0) ? (UT + (long)c * NTOK + tokbase)
                                 : ((const u16*)((char*)p.out + OFF_Z1T) + (long)c * NTOK + tokbase);
  const int gch = 512 * (order + 1) + c;
  const u16* gsrc = UT + (long)gch * NTOK + tokbase;
  u16* dst = ((order == 0) ? (u16*)((char*)p.out + OFF_Z1T) : (u16*)(p.ws + OFF_Z2T)) + (long)c * NTOK + tokbase;

  __syncthreads();
#pragma unroll 2
  for (int i = tid; i < LG / 8; i += 512) *(uint4*)(grl + i * 8) = *(const uint4*)(GRg + i * 8);
  {
    const uint4 z4 = make_uint4(0, 0, 0, 0);
    for (int i = tid; i < HY_ZBYTES / 16; i += 512) *(uint4*)(smem + HY_ZOFF + i * 16) = z4;
    for (int i = tid; i < (P >> 3); i += 512) { int x = i * 8; *(uint4*)(us + PHYS(x)) = z4; }
    for (int i = tid; i < NB * (P >> 3); i += 512) {
      int g = i / (P >> 3), r = i - g * (P >> 3);
      int x = P + g * BS + L + r * 8;
      *(uint4*)(us + PHYS(x)) = z4;
    }
  }
  if (order == 0) {
    const float cb = p.conv_b[c], w0 = p.conv_w[c], w1 = p.conv_w[1536 + c], w2 = p.conv_w[3072 + c];
#pragma unroll 1
    for (int i = tid; i < 4096; i += 512) {
      int tau = i * 8, b = tau >> LSH, t = tau & (L - 1);
      int x = P + b * BS + t;
      *(uint4*)(us + PHYS(x)) = conv8(usrc, tau, t, L, cb, w0, w1, w2);
    }
  } else {
#pragma unroll 2
    for (int i = tid; i < 4096; i += 512) {
      int tau = i * 8, b = tau >> LSH, t = tau & (L - 1);
      int x = P + b * BS + t;
      *(uint4*)(us + PHYS(x)) = *(const uint4*)(usrc + tau);
    }
  }
  __syncthreads();

  const int n = lane & 31, h = lane >> 5;
  int grp, idx;
  if (n < 4) { grp = 0; idx = n; } else if (n < 12) { grp = 1; idx = n - 4; } else if (n < 16) { grp = 0; idx = n - 8; }
  else if (n < 20) { grp = 1; idx = n - 8; } else if (n < 28) { grp = 0; idx = n - 12; } else { grp = 1; idx = n - 16; }
  const int bat = SAMP ? grp : (4 * grp + (idx & 3));
  const int ii = SAMP ? idx : (idx >> 2);
  const int ebase = L + 32 - n + 8 * h;
  const unsigned sh = (unsigned)(ebase & 1) * 16u;
  f32x16 acc0, acc1, acc2, acc3;
#pragma unroll
  for (int j = 0; j < 16; ++j) { acc0[j] = 0.f; acc1[j] = 0.f; acc2[j] = 0.f; acc3[j] = 0.f; }
  const int o0 = P * 4 * w;
  const int base_hi = o0 + 4 * P - 32;
  constexpr int npairs = (L + 4 * P - 32) / 32;
  constexpr int smin = -(P - 32), smaxp = L - 32;
  int va = HY_GRL_OFF + ((ebase >> 1) << 2) - 2 * base_hi;
  int vb = 2 * (8 * h + 40 * ii + bat * (BS * 5 / 4)) + 2 * ((-3 * P + 32) * 5 / 4);
  const int vz = HY_ZOFF;
  int s0 = -4 * P + 32;

#define HY_LD(SFX, VA, A0, A1, A2, A3, IMM) do { \
    const unsigned* gp_ = (const unsigned*)(smem + (VA) + (IMM)); \
    d0##SFX = gp_[0]; d1##SFX = gp_[1]; d2##SFX = gp_[2]; d3##SFX = gp_[3]; d4##SFX = gp_[4]; \
    b0##SFX = *(const bf16x8*)(smem + (A0) + (IMM)); \
    b1##SFX = *(const bf16x8*)(smem + (A1) + TB + (IMM)); \
    b2##SFX = *(const bf16x8*)(smem + (A2) + 2 * TB + (IMM)); \
    b3##SFX = *(const bf16x8*)(smem + (A3) + 3 * TB + (IMM)); } while (0)
#define HY_MMA(SFX) do { \
    union { unsigned u[4]; bf16x8 v; } A_; \
    A_.u[0] = __builtin_amdgcn_alignbit(d1##SFX, d0##SFX, sh); \
    A_.u[1] = __builtin_amdgcn_alignbit(d2##SFX, d1##SFX, sh); \
    A_.u[2] = __builtin_amdgcn_alignbit(d3##SFX, d2##SFX, sh); \
    A_.u[3] = __builtin_amdgcn_alignbit(d4##SFX, d3##SFX, sh); \
    acc0 = __builtin_amdgcn_mfma_f32_32x32x16_bf16(A_.v, b0##SFX, acc0, 0, 0, 0); \
    acc1 = __builtin_amdgcn_mfma_f32_32x32x16_bf16(A_.v, b1##SFX, acc1, 0, 0, 0); \
    acc2 = __builtin_amdgcn_mfma_f32_32x32x16_bf16(A_.v, b2##SFX, acc2, 0, 0, 0); \
    acc3 = __builtin_amdgcn_mfma_f32_32x32x16_bf16(A_.v, b3##SFX, acc3, 0, 0, 0); } while (0)
#define HY_SEL(S) do { \
    e0 = ((S) >= smin && (S) <= smaxp) ? vb : vz; \
    e1 = ((S) + P >= smin && (S) + P <= smaxp) ? vb : vz; \
    e2 = ((S) + 2 * P >= smin && (S) + 2 * P <= smaxp) ? vb : vz; \
    e3 = ((S) + 3 * P >= smin && (S) + 3 * P <= smaxp) ? vb : vz; } while (0)
  {
    unsigned d0x, d1x, d2x, d3x, d4x, d0y, d1y, d2y, d3y, d4y;
    bf16x8 b0x, b1x, b2x, b3x, b0y, b1y, b2y, b3y;
    int e0, e1, e2, e3;
    HY_SEL(s0);
    HY_LD(x, va, e0, e1, e2, e3, 0);
    HY_LD(y, va, e0, e1, e2, e3, 32);
    for (int j = 0; j < npairs; ++j) {
      __builtin_amdgcn_sched_barrier(0);
      HY_MMA(x);
      __builtin_amdgcn_sched_barrier(0);
      s0 += 32;
      vb += 80;
      va += (j + 1 < npairs) ? 64 : 0;
      HY_SEL(s0);
      HY_LD(x, va, e0, e1, e2, e3, 0);
      __builtin_amdgcn_sched_barrier(0);
      HY_MMA(y);
      __builtin_amdgcn_sched_barrier(0);
      HY_LD(y, va, e0, e1, e2, e3, 32);
    }
  }
  __syncthreads();
  {
    const float cb = p.conv_b[gch], w0 = p.conv_w[gch], w1 = p.conv_w[1536 + gch], w2 = p.conv_w[3072 + gch];
#pragma unroll 1
    for (int i = tid; i < 4096; i += 512) {
      int tau = i * 8, t = tau & (L - 1);
      *(uint4*)(grl + tau) = conv8(gsrc, tau, t, L, cb, w0, w1, w2);
    }
  }
  __syncthreads();
  const float dv = p.hyd[order * 512 + c];
#define HY_EPI(ACC, R) do { \
    _Pragma("unroll") for (int g4 = 0; g4 < 4; ++g4) { \
      int t = o0 + P * (R) + 8 * g4 + 4 * h + 32 * ii; \
      int tau = (bat << LSH) + t; \
      int ue_ = P + bat * BS + t; \
      uint2 uu = *(const uint2*)(us + PHYS(ue_)); \
      uint2 gg = *(const uint2*)(grl + tau); \
      float y0 = bflo(gg.x) * (ACC[4 * g4 + 0] + dv * bflo(uu.x)); \
      float y1 = bfhi(gg.x) * (ACC[4 * g4 + 1] + dv * bfhi(uu.x)); \
      float y2 = bflo(gg.y) * (ACC[4 * g4 + 2] + dv * bflo(uu.y)); \
      float y3 = bfhi(gg.y) * (ACC[4 * g4 + 3] + dv * bfhi(uu.y)); \
      uint2 oo; oo.x = pack2(y0, y1); oo.y = pack2(y2, y3); \
      *(uint2*)(dst + tau) = oo; \
    } } while (0)
  HY_EPI(acc0, 0); HY_EPI(acc1, 1); HY_EPI(acc2, 2); HY_EPI(acc3, 3);
}

__device__ void hyena_phase(const Params& p, int order, char* smem) {
  for (int b = blockIdx.x; b < 256; b += gridDim.x) {
#pragma unroll 1
    for (int u = 0; u < 2; ++u) hyena_unit<true>(p, order, b + 256 * u, smem);
#pragma unroll 1
    for (int u = 0; u < 2; ++u) hyena_unit<false>(p, order, b + 256 * u, smem);
  }
}
__global__ void __launch_bounds__(512) k_hyena(Params p, int order) {
  extern __shared__ __attribute__((aligned(16))) char smem[];
  hyena_phase(p, order, smem);
}

#define VSTR 144
#define ATT_WAVE_LDS (32 * VSTR)
typedef short v4s __attribute__((ext_vector_type(4)));
typedef __attribute__((address_space(3))) v4s* lds_v4s_ptr;

__device__ __forceinline__ void attn_item(const Params& p, int item, char* vl, int lane) {
  int seqbase, L, head, r, ib;
  if (item < 8192) { int sq = item >> 10, rem = item & 1023; seqbase = sq * 4096; L = 4096; head = rem >> 7; r = (rem >> 3) & 15; ib = rem & 7; }
  else { int it2 = item - 8192; int sq = it2 >> 12, rem = it2 & 4095; seqbase = 32768 + sq * 16384; L = 16384; head = rem >> 9; r = (rem >> 5) & 15; ib = rem & 31; }
  const int n = lane & 31, h = lane >> 5;
  const int tmin = r + 512 * ib;
  const int tq = tmin + 16 * n;
  u16* Qb = (u16*)(p.ws + OFF_QB);
  const u16* Kb = (const u16*)(p.ws + OFF_KB) + head * 64;
  const u16* Vb = (const u16*)(p.ws + OFF_VB) + head * 64;
  u16* qrow = Qb + (long)(seqbase + tq) * 512 + head * 64;
  bf16x8 qf0 = *(const bf16x8*)(qrow + 8 * h), qf1 = *(const bf16x8*)(qrow + 16 + 8 * h),
         qf2 = *(const bf16x8*)(qrow + 32 + 8 * h), qf3 = *(const bf16x8*)(qrow + 48 + 8 * h);
  f32x16 o0, o1;
#pragma unroll
  for (int j = 0; j < 16; ++j) { o0[j] = 0.f; o1[j] = 0.f; }
  float m_run = -1e30f, l_run = 0.f;
  const float nslope = -exp2f(-(float)(head + 1)) * LOG2E;
  const int g = lane >> 4, i16 = lane & 15, tq4 = i16 >> 2, tp4 = i16 & 3;
  const int troff = (4 * (g >> 1) + tq4) * VSTR + (16 * (g & 1) + 4 * tp4) * 2;
  const int vkey0 = lane >> 3, vpart = lane & 7;

  for (int pat = 0; pat < 3; ++pat) {
    const int dil = (pat == 0) ? 1 : (pat == 1 ? 4 : 16);
    const int ntile = (pat == 0) ? 20 : (pat == 1 ? 8 : 5);
    const int kbase = tmin - 64 * dil;
    const float fd = (float)dil;
    const float dl0 = (float)(-64 * dil - 16 * n + 4 * h * dil);
    const float lo = fmaxf(-64.f * fd, -(float)tq);
    const float hi = fminf(64.f * fd, (float)(L - 1 - tq));
    for (int j = 0; j < ntile; ++j) {
      const int tk0 = kbase + 32 * j * dil;
      if (tk0 + 31 * dil < 0 || tk0 >= L) continue;
      int tk = tk0 + n * dil; tk = min(max(tk, 0), L - 1);
      const u16* krow = Kb + (long)(seqbase + tk) * 512 + 8 * h;
      bf16x8 kf0 = *(const bf16x8*)(krow), kf1 = *(const bf16x8*)(krow + 16), kf2 = *(const bf16x8*)(krow + 32), kf3 = *(const bf16x8*)(krow + 48);
#pragma unroll
      for (int it4 = 0; it4 < 4; ++it4) {
        int key = vkey0 + 8 * it4;
        int tv = tk0 + key * dil; tv = min(max(tv, 0), L - 1);
        uint4 vv = *(const uint4*)(Vb + (long)(seqbase + tv) * 512 + vpart * 8);
        *(uint4*)(vl + key * VSTR + vpart * 16) = vv;
      }
      f32x16 S;
#pragma unroll
      for (int jj = 0; jj < 16; ++jj) S[jj] = 0.f;
      S = __builtin_amdgcn_mfma_f32_32x32x16_bf16(kf0, qf0, S, 0, 0, 0);
      S = __builtin_amdgcn_mfma_f32_32x32x16_bf16(kf1, qf1, S, 0, 0, 0);
      S = __builtin_amdgcn_mfma_f32_32x32x16_bf16(kf2, qf2, S, 0, 0, 0);
      S = __builtin_amdgcn_mfma_f32_32x32x16_bf16(kf3, qf3, S, 0, 0, 0);
      const float dt = dl0 + (float)(32 * j * dil);
      float mx = -1e30f;
      bool valid[16];
#pragma unroll
      for (int jj = 0; jj < 16; ++jj) {
        float delta = dt + fd * (float)((jj & 3) + 8 * (jj >> 2));
        valid[jj] = (delta >= lo) && (delta <= hi);
        float sc = S[jj] + nslope * fabsf(delta);
        sc = valid[jj] ? sc : -1e30f;
        S[jj] = sc;
        mx = fmaxf(mx, sc);
      }
      mx = fmaxf(mx, __shfl_xor(mx, 32));
      const float m_new = fmaxf(m_run, mx);
      const float alpha = __builtin_amdgcn_exp2f(m_run - m_new);
      m_run = m_new;
      float psum = 0.f;
      float pv[16];
#pragma unroll
      for (int jj = 0; jj < 16; ++jj) {
        float pe = valid[jj] ? __builtin_amdgcn_exp2f(S[jj] - m_new) : 0.f;
        pv[jj] = pe; psum += pe;
      }
      l_run = l_run * alpha + psum;
#pragma unroll
      for (int jj = 0; jj < 16; ++jj) { o0[jj] *= alpha; o1[jj] *= alpha; }
      union { unsigned u[4]; bf16x8 v; } pf0, pf1;
#pragma unroll
      for (int q = 0; q < 4; ++q) { pf0.u[q] = pack2(pv[2 * q], pv[2 * q + 1]); pf1.u[q] = pack2(pv[8 + 2 * q], pv[8 + 2 * q + 1]); }
      __builtin_amdgcn_wave_barrier();
#define TRRD(s2, hh, dtt) __builtin_amdgcn_ds_read_tr16_b64_v4i16((lds_v4s_ptr)(vl + troff + (16 * (s2) + 8 * (hh)) * VSTR + 64 * (dtt)))
      {
        v4s a00 = TRRD(0, 0, 0), a01 = TRRD(0, 1, 0), b00 = TRRD(0, 0, 1), b01 = TRRD(0, 1, 1);
        v4s a10 = TRRD(1, 0, 0), a11 = TRRD(1, 1, 0), b10 = TRRD(1, 0, 1), b11 = TRRD(1, 1, 1);
        bf16x8 va0 = __builtin_shufflevector(a00, a01, 0, 1, 2, 3, 4, 5, 6, 7);
        bf16x8 vb0 = __builtin_shufflevector(b00, b01, 0, 1, 2, 3, 4, 5, 6, 7);
        bf16x8 va1 = __builtin_shufflevector(a10, a11, 0, 1, 2, 3, 4, 5, 6, 7);
        bf16x8 vb1 = __builtin_shufflevector(b10, b11, 0, 1, 2, 3, 4, 5, 6, 7);
        o0 = __builtin_amdgcn_mfma_f32_32x32x16_bf16(va0, pf0.v, o0, 0, 0, 0);
        o1 = __builtin_amdgcn_mfma_f32_32x32x16_bf16(vb0, pf0.v, o1, 0, 0, 0);
        o0 = __builtin_amdgcn_mfma_f32_32x32x16_bf16(va1, pf1.v, o0, 0, 0, 0);
        o1 = __builtin_amdgcn_mfma_f32_32x32x16_bf16(vb1, pf1.v, o1, 0, 0, 0);
      }
      __builtin_amdgcn_wave_barrier();
    }
  }
  const float ltot = l_run + __shfl_xor(l_run, 32);
  const float inv = 1.f / ltot;
#pragma unroll
  for (int g4 = 0; g4 < 4; ++g4) {
    uint2 w0, w1;
    w0.x = pack2(o0[4 * g4] * inv, o0[4 * g4 + 1] * inv); w0.y = pack2(o0[4 * g4 + 2] * inv, o0[4 * g4 + 3] * inv);
    w1.x = pack2(o1[4 * g4] * inv, o1[4 * g4 + 1] * inv); w1.y = pack2(o1[4 * g4 + 2] * inv, o1[4 * g4 + 3] * inv);
    *(uint2*)(qrow + 8 * g4 + 4 * h) = w0;
    *(uint2*)(qrow + 32 + 8 * g4 + 4 * h) = w1;
  }
}

__device__ void attn_phase(const Params& p, char* smem) {
  const int lane = threadIdx.x & 63, w = threadIdx.x >> 6;
  char* vl = smem + w * ATT_WAVE_LDS;
  __syncthreads();
  const int nwaves = gridDim.x * 8;
  const int per = (16384 + nwaves - 1) / nwaves;
  const int gw = blockIdx.x * 8 + w;
  for (int k = 0; k < per; ++k) {
    int item = gw * per + k;
    if (item < 16384) attn_item(p, item, vl, lane);
  }
}
#define ATTN_PHASE(p, smem) attn_phase(p, smem)

#define MEGA_LDS HY_LDS
#ifndef PROBE_DOUBLE
#define PROBE_DOUBLE 0
#endif
#ifndef ATTN_PHASE
#define ATTN_PHASE(p, smem) attn_naive_phase(p)
#endif

__global__ void __launch_bounds__(512) mega(Params p) {
  extern __shared__ __attribute__((aligned(16))) char smem[];
  cg::grid_group grid = cg::this_grid();
  phase0(p, smem);
#if PROBE_DOUBLE == 1
  grid.sync();
  phase0(p, smem);
#endif
  grid.sync();
  phase1(p, smem);
#if PROBE_DOUBLE == 2
  grid.sync();
  phase1(p, smem);
#endif
  grid.sync();
  hyena_phase(p, 0, smem);
#if PROBE_DOUBLE == 3
  hyena_phase(p, 0, smem);
#endif
  ATTN_PHASE(p, smem);
  grid.sync();
  convert_wout(p);
  hyena_phase(p, 1, smem);
  grid.sync();
  phase4(p, smem);
#if PROBE_DOUBLE == 4
  grid.sync();
  phase4(p, smem);
#endif
}

static Params make_params(void* const* d_in, void* d_out, void* d_ws) {
  Params p{};
  p.x0 = (const float*)d_in[0]; p.x1 = (const float*)d_in[1]; p.w_in = (const float*)d_in[2];
  p.conv_w = (const float*)d_in[3]; p.conv_b = (const float*)d_in[4];
  p.fw1 = (const float*)d_in[5]; p.fb1 = (const float*)d_in[6]; p.fw2 = (const float*)d_in[7]; p.fb2 = (const float*)d_in[8];
  p.fw3 = (const float*)d_in[9]; p.fb3 = (const float*)d_in[10]; p.ffreq = (const float*)d_in[11]; p.fw4 = (const float*)d_in[12];
  p.hyd = (const float*)d_in[13]; p.gna = (const float*)d_in[14]; p.gnh = (const float*)d_in[15];
  p.w_out = (const float*)d_in[16]; p.lng = (const float*)d_in[17]; p.lnb = (const float*)d_in[18];
  p.out = (float*)d_out; p.ws = (char*)d_ws;
  return p;
}

extern "C" void kernel_launch(void* const* d_in, const int* in_sizes, int n_in,
                              void* d_out, int out_size, void* d_ws, size_t ws_size,
                              hipStream_t stream) {
  Params p = make_params(d_in, d_out, d_ws);
  static int grid_blocks = 0;
  if (!grid_blocks) {
    (void)hipFuncSetAttribute((const void*)mega, hipFuncAttributeMaxDynamicSharedMemorySize, MEGA_LDS);
    int dev = 0, cus = 0, per_cu = 0;
    (void)hipGetDevice(&dev);
    (void)hipDeviceGetAttribute(&cus, hipDeviceAttributeMultiprocessorCount, dev);
    (void)hipOccupancyMaxActiveBlocksPerMultiprocessor(&per_cu, mega, 512, MEGA_LDS);
    if (per_cu < 1) per_cu = 1;
    grid_blocks = cus;
    if (grid_blocks > 256) grid_blocks = 256;
  }
  void* args[] = {&p};
  hipError_t e = hipLaunchCooperativeKernel((void*)mega, dim3(grid_blocks), dim3(512), args, MEGA_LDS, stream);
  if (e != hipSuccess) fprintf(stderr, "cooperative launch failed: %s (grid %d)\n", hipGetErrorString(e), grid_blocks);
}
```

```cpp
#include <hip/hip_runtime.h>
#include <hip/hip_cooperative_groups.h>
#include <cstdio>
namespace cg = cooperative_groups;

typedef unsigned short u16;
typedef short bf16x8 __attribute__((ext_vector_type(8)));
typedef short s16x4 __attribute__((ext_vector_type(4)));
typedef float f32x16 __attribute__((ext_vector_type(16)));
typedef float f32x2 __attribute__((ext_vector_type(2)));

#define NTOK 65536
#define MiB (1024L * 1024L)
#define OFF_QB (0 * MiB)
#define OFF_KB (64 * MiB)
#define OFF_VB (128 * MiB)
#define OFF_GB (192 * MiB)
#define OFF_UT (320 * MiB)
#define OFF_MIXED (64 * MiB)
#define OFF_WBOUT (384 * MiB)
#define OFF_Z2T (320 * MiB)
#define OFF_XB (0 * MiB)
#define OFF_Z1T (0 * MiB)
#define OFF_Z0T (64 * MiB)
#define LG_S 32832
#define LG_P 8256
#define OFF_GRS (128 * MiB)
#define OFF_GRP (128 * MiB + 1024L * LG_S * 2)
#define OFF_WBIN (212 * MiB)

__device__ unsigned short g_wbout[1024 * 1024];

struct Params {
  const float *x0, *x1, *w_in, *conv_w, *conv_b, *fw1, *fb1, *fw2, *fb2, *fw3, *fb3, *ffreq, *fw4, *hyd, *gna, *gnh, *w_out, *lng, *lnb;
  float* out;
  char* ws;
};

__device__ __forceinline__ u16 f2bf(float f) {
  unsigned u = __float_as_uint(f);
  u += 0x7fffu + ((u >> 16) & 1u);
  return (u16)(u >> 16);
}
__device__ __forceinline__ float bf2f(u16 b) { return __uint_as_float(((unsigned)b) << 16); }
__device__ __forceinline__ unsigned pack2(float a, float b) { return (unsigned)f2bf(a) | ((unsigned)f2bf(b) << 16); }
__device__ __forceinline__ float bflo(unsigned u) { return __uint_as_float(u << 16); }
__device__ __forceinline__ float bfhi(unsigned u) { return __uint_as_float(u & 0xffff0000u); }
__device__ __forceinline__ float silu_f(float x) { return x / (1.f + __expf(-x)); }

__device__ __forceinline__ void tok_info(int tok, int& t, int& L, int& seqbase) {
  if (tok < 32768) { L = 4096; t = tok & 4095; seqbase = tok & ~4095; }
  else { L = 16384; t = tok & 16383; seqbase = tok & ~16383; }
}

__device__ __forceinline__ void filter_item(const Params& p, int item, char* smem) {
  const int tid = threadIdx.x;
  const bool samp = item < 1024;
  const int L = samp ? 16384 : 4096;
  const int LG = samp ? LG_S : LG_P;
  const int it2 = samp ? item : item - 1024;
  const int q = it2 & 3;
  const int l0 = (it2 >> 2) * 64;
  const int n = q >> 1, dir = q & 1;
  const int lagbase = l0 + (dir == 0 ? 1 : 0);
  u16* GR = (u16*)((char*)p.out + (samp ? OFF_GRS : OFF_GRP));
  float* zs = (float*)smem;
  float* ha = zs + 64 * 36;
  float* hb = ha + 64 * 64;
  __syncthreads();
  for (int i = tid; i < 64 * 33; i += 512) {
    int l = i / 33, f = i - l * 33;
    int lag = lagbase + l;
    float t = (float)lag / (float)(L - 1);
    float w = (float)lag / (float)L;
    float v;
    if (f == 0) v = t;
    else {
      int j = (f - 1) & 15;
      float fr = 1e-4f + (float)j * ((15.0f - 1e-4f) / 15.0f);
      float a = fr * w;
      v = (f <= 16) ? __builtin_amdgcn_cosf(a) : -__builtin_amdgcn_sinf(a);
    }
    zs[l * 36 + f] = v;
  }
  __syncthreads();
  {
    const int u = tid & 63, lb = tid >> 6;
    float acc[8];
    const float bb = p.fb1[u];
#pragma unroll
    for (int qq = 0; qq < 8; ++qq) acc[qq] = bb;
#pragma unroll 4
    for (int f = 0; f < 33; ++f) {
      const float wv = p.fw1[f * 64 + u];
#pragma unroll
      for (int qq = 0; qq < 8; ++qq) acc[qq] += zs[(lb + 8 * qq) * 36 + f] * wv;
    }
    const float fq = p.ffreq[0 + u];
#pragma unroll
    for (int qq = 0; qq < 8; ++qq) { const int l = lb + 8 * qq; ha[l * 64 + u] = __sinf(fq * acc[qq]); }
  }
  __syncthreads();
  {
    const int u = tid & 63, lb = tid >> 6;
    float acc[8];
    const float bb = p.fb2[u];
#pragma unroll
    for (int qq = 0; qq < 8; ++qq) acc[qq] = bb;
#pragma unroll 4
    for (int f = 0; f < 64; ++f) {
      const float wv = p.fw2[f * 64 + u];
#pragma unroll
      for (int qq = 0; qq < 8; ++qq) acc[qq] += ha[(lb + 8 * qq) * 64 + f] * wv;
    }
    const float fq = p.ffreq[64 + u];
#pragma unroll
    for (int qq = 0; qq < 8; ++qq) { const int l = lb + 8 * qq; hb[l * 64 + u] = __sinf(fq * acc[qq]); }
  }
  __syncthreads();
  {
    const int u = tid & 63, lb = tid >> 6;
    float acc[8];
    const float bb = p.fb3[u];
#pragma unroll
    for (int qq = 0; qq < 8; ++qq) acc[qq] = bb;
#pragma unroll 4
    for (int f = 0; f < 64; ++f) {
      const float wv = p.fw3[f * 64 + u];
#pragma unroll
      for (int qq = 0; qq < 8; ++qq) acc[qq] += hb[(lb + 8 * qq) * 64 + f] * wv;
    }
    const float fq = p.ffreq[128 + u];
#pragma unroll
    for (int qq = 0; qq < 8; ++qq) { const int l = lb + 8 * qq; ha[u * 64 + l] = __sinf(fq * acc[qq]); }
  }
  __syncthreads();
  const int c = tid;
  const float min_decay = -3.0701134573253943f;
  const float max_decay = -15.350567286626972f;
  const float delta = fabsf(min_decay + (max_decay - min_decay) * ((float)c / 511.0f));
  f32x2 acc2[32];
#pragma unroll
  for (int l = 0; l < 32; ++l) acc2[l] = (f32x2){0.f, 0.f};
  float a0 = 0.f;
  const bool need0 = (dir == 1) && (l0 == 0);
  float wnext = p.fw4[q * 512 + c];
#pragma unroll 1
  for (int j = 0; j < 64; ++j) {
    const float wv = wnext;
    wnext = p.fw4[((j + 1) & 63) * 2048 + q * 512 + c];
    const float4* hr = (const float4*)(ha + j * 64);
    const f32x2 wv2 = {wv, wv};
#pragma unroll
    for (int l4 = 0; l4 < 16; ++l4) {
      float4 hv = hr[l4];
      f32x2 h01 = {hv.x, hv.y}, h23 = {hv.z, hv.w};
      acc2[2 * l4] = __builtin_elementwise_fma(h01, wv2, acc2[2 * l4]);
      acc2[2 * l4 + 1] = __builtin_elementwise_fma(h23, wv2, acc2[2 * l4 + 1]);
    }
    if (need0) a0 += ha[j * 64] * p.fw4[j * 2048 + (q - 1) * 512 + c];
  }
  float acc[64];
#pragma unroll
  for (int l = 0; l < 32; ++l) { acc[2 * l] = acc2[l][0]; acc[2 * l + 1] = acc2[l][1]; }
  if (need0) acc[0] = a0;
  const float tinv = 1.f / (float)(L - 1);
#pragma unroll
  for (int l = 0; l < 64; ++l) {
    int lag = lagbase + l;
    float v = acc[l] * expf(-(float)lag * tinv * delta);
    acc[l] = (lag >= L) ? 0.f : v;
  }
  u16* row = GR + (long)(n * 512 + c) * LG;
  if (dir == 1) {
    u16* dst = row + (L + 32 + l0);
#pragma unroll
    for (int e = 0; e < 8; ++e) {
      uint4 o;
      o.x = pack2(acc[8 * e + 0], acc[8 * e + 1]); o.y = pack2(acc[8 * e + 2], acc[8 * e + 3]);
      o.z = pack2(acc[8 * e + 4], acc[8 * e + 5]); o.w = pack2(acc[8 * e + 6], acc[8 * e + 7]);
      *(uint4*)(dst + 8 * e) = o;
    }
  } else {
    u16* dst = row + (L + 32 - l0 - 64);
#pragma unroll
    for (int e = 0; e < 8; ++e) {
      uint4 o;
      o.x = pack2(acc[63 - 8 * e], acc[62 - 8 * e]); o.y = pack2(acc[61 - 8 * e], acc[60 - 8 * e]);
      o.z = pack2(acc[59 - 8 * e], acc[58 - 8 * e]); o.w = pack2(acc[57 - 8 * e], acc[56 - 8 * e]);
      *(uint4*)(dst + 8 * e) = o;
    }
    if (l0 == 0) {
      const uint4 z4 = make_uint4(0, 0, 0, 0);
#pragma unroll
      for (int e = 0; e < 4; ++e) { *(uint4*)(row + 8 * e) = z4; *(uint4*)(row + 2 * L + 32 + 8 * e) = z4; }
    }
  }
}

__device__ __forceinline__ void phase0_convert(const Params& p) {
  const int tid = threadIdx.x, bid = blockIdx.x, nb = gridDim.x;
  u16* xb = (u16*)((char*)p.out + OFF_XB);
  const long nchunk = (long)NTOK * 1024 / 8;
  for (long c0 = (long)bid * 512 + tid; c0 < nchunk; c0 += (long)nb * 512 * 8) {
    float4 a[8], b[8];
#pragma unroll
    for (int q = 0; q < 8; ++q) {
      long cc = c0 + (long)q * nb * 512; if (cc >= nchunk) cc = c0;
      long e = cc * 8;
      const float* src = (e < 32768L * 1024) ? (p.x0 + e) : (p.x1 + (e - 32768L * 1024));
      a[q] = *(const float4*)src; b[q] = *(const float4*)(src + 4);
    }
#pragma unroll
    for (int q = 0; q < 8; ++q) {
      long cc = c0 + (long)q * nb * 512; if (cc >= nchunk) cc = c0;
      long e = cc * 8;
      uint4 o;
      o.x = pack2(a[q].x, a[q].y); o.y = pack2(a[q].z, a[q].w); o.z = pack2(b[q].x, b[q].y); o.w = pack2(b[q].z, b[q].w);
      *(uint4*)(xb + e) = o;
    }
  }
  u16* wbin = (u16*)((char*)p.out + OFF_WBIN);
  for (int id = bid * 512 + tid; id < 4096 * 128; id += nb * 512) {
    int n = id & 4095, kc = id >> 12;
    float v[8];
#pragma unroll
    for (int j = 0; j < 8; ++j) v[j] = p.w_in[(long)(kc * 8 + j) * 4096 + n];
    uint4 o;
    o.x = pack2(v[0], v[1]); o.y = pack2(v[2], v[3]); o.z = pack2(v[4], v[5]); o.w = pack2(v[6], v[7]);
    *(uint4*)(wbin + (long)n * 1024 + kc * 8) = o;
  }
}

__device__ __forceinline__ void phase0(const Params& p, char* smem) {
  const int bid = blockIdx.x, nb = gridDim.x;
  if (bid & 1) {
    for (int item = bid; item < 1280; item += nb) filter_item(p, item, smem);
    phase0_convert(p);
  } else {
    phase0_convert(p);
    for (int item = bid; item < 1280; item += nb) filter_item(p, item, smem);
  }
}

__device__ __forceinline__ void convert_wout(const Params& p) {
  const int tid = threadIdx.x, bid = blockIdx.x, nb = gridDim.x;
  u16* wb = g_wbout;
  for (int id = bid * 512 + tid; id < 1024 * 128; id += nb * 512) {
    int n = id & 1023, kc = id >> 10;
    float v[8];
#pragma unroll
    for (int j = 0; j < 8; ++j) v[j] = p.w_out[(long)(kc * 8 + j) * 1024 + n];
    uint4 o;
    o.x = pack2(v[0], v[1]); o.y = pack2(v[2], v[3]); o.z = pack2(v[4], v[5]); o.w = pack2(v[6], v[7]);
    *(uint4*)(wb + (long)n * 1024 + kc * 8) = o;
  }
}

#define QSCALE 0.18033688011112042f
#define LOG2E 1.4426950408889634f

__device__ __forceinline__ void inproj_store1(const Params& p, int tok, int col, float v) {
  u16* ws16 = (u16*)p.ws;
  if (col < 512) ws16[(OFF_QB >> 1) + (long)tok * 512 + col] = f2bf(v * QSCALE);
  else if (col < 1024) ws16[(OFF_KB >> 1) + (long)tok * 512 + (col - 512)] = f2bf(v);
  else if (col < 1536) ws16[(OFF_VB >> 1) + (long)tok * 512 + (col - 1024)] = f2bf(v);
  else if (col < 2048) ws16[(OFF_GB >> 1) + (long)tok * 1024 + (col - 1536)] = f2bf(silu_f(v));
  else if (col < 3584) ws16[(OFF_UT >> 1) + (long)(col - 2048) * NTOK + tok] = f2bf(v);
  else ws16[(OFF_GB >> 1) + (long)tok * 1024 + 512 + (col - 3584)] = f2bf(silu_f(v));
}

__device__ __forceinline__ float shortconv_at(const Params& p, int ch, int tok) {
  const u16* row = (const u16*)(p.ws + OFF_UT) + (long)ch * NTOK;
  int t, L, sb; tok_info(tok, t, L, sb);
  float a = (t > 0) ? bf2f(row[tok - 1]) : 0.f;
  float b = bf2f(row[tok]);
  float c = (t < L - 1) ? bf2f(row[tok + 1]) : 0.f;
  return p.conv_b[ch] + p.conv_w[ch] * a + p.conv_w[1536 + ch] * b + p.conv_w[3072 + ch] * c;
}

__global__ void __launch_bounds__(512) k_phase0(Params p) {
  extern __shared__ __attribute__((aligned(16))) char smem[];
  phase0(p, smem);
}
__global__ void __launch_bounds__(512) k_convert_wout(Params p) { convert_wout(p); }

__global__ void __launch_bounds__(256) n_inproj(Params p) {
  long gid = (long)blockIdx.x * 256 + threadIdx.x;
  int col = (int)(gid & 4095), tok = (int)(gid >> 12);
  const u16* xb = (const u16*)((char*)p.out + OFF_XB) + (long)tok * 1024;
  const u16* wb = (const u16*)((char*)p.out + OFF_WBIN) + (long)col * 1024;
  float acc = 0.f;
  for (int k = 0; k < 1024; k += 8) {
    uint4 a = *(const uint4*)(xb + k), b = *(const uint4*)(wb + k);
    acc += bflo(a.x) * bflo(b.x) + bfhi(a.x) * bfhi(b.x) + bflo(a.y) * bflo(b.y) + bfhi(a.y) * bfhi(b.y)
         + bflo(a.z) * bflo(b.z) + bfhi(a.z) * bfhi(b.z) + bflo(a.w) * bflo(b.w) + bfhi(a.w) * bfhi(b.w);
  }
  inproj_store1(p, tok, col, acc);
}

__global__ void __launch_bounds__(256) n_attn(Params p) {
  int gid = blockIdx.x * 256 + threadIdx.x;
  int tok = gid & 65535, head = gid >> 16;
  int t, L, sb; tok_info(tok, t, L, sb);
  u16* Qb = (u16*)(p.ws + OFF_QB);
  const u16* Kb = (const u16*)(p.ws + OFF_KB);
  const u16* Vb = (const u16*)(p.ws + OFF_VB);
  float q[64], o[64];
#pragma unroll
  for (int d = 0; d < 64; ++d) { q[d] = bf2f(Qb[(long)tok * 512 + head * 64 + d]); o[d] = 0.f; }
  float m = -1e30f, l = 0.f;
  const float slope2 = exp2f(-(float)(head + 1)) * LOG2E;
  for (int pat = 0; pat < 3; ++pat) {
    int dil = (pat == 0) ? 1 : (pat == 1 ? 4 : 16);
    for (int j = -64; j <= 64; ++j) {
      int tk = t + j * dil;
      if (tk < 0 || tk >= L) continue;
      const u16* kr = Kb + (long)(sb + tk) * 512 + head * 64;
      const u16* vr = Vb + (long)(sb + tk) * 512 + head * 64;
      float s = 0.f;
#pragma unroll
      for (int d = 0; d < 64; ++d) s += q[d] * bf2f(kr[d]);
      s -= slope2 * (float)(abs(j) * dil);
      if (s > m) {
        float sc = exp2f(m - s);
        l *= sc;
#pragma unroll
        for (int d = 0; d < 64; ++d) o[d] *= sc;
        m = s;
      }
      float pr = exp2f(s - m);
      l += pr;
#pragma unroll
      for (int d = 0; d < 64; ++d) o[d] += pr * bf2f(vr[d]);
    }
  }
  float inv = 1.f / l;
#pragma unroll
  for (int d = 0; d < 64; ++d) Qb[(long)tok * 512 + head * 64 + d] = f2bf(o[d] * inv);
}

__global__ void __launch_bounds__(256) n_z0(Params p) {
  int gid = blockIdx.x * 256 + threadIdx.x;
  int tok = gid & 65535, c = gid >> 16;
  u16* z0 = (u16*)((char*)p.out + OFF_Z0T);
  z0[(long)c * NTOK + tok] = f2bf(shortconv_at(p, c, tok));
}

__global__ void __launch_bounds__(256) n_conv(Params p, int order) {
  int gid = blockIdx.x * 256 + threadIdx.x;
  int tok = gid & 65535, c = gid >> 16;
  int t, L, sb; tok_info(tok, t, L, sb);
  const bool samp = tok >= 32768;
  const u16* src = (order == 0) ? (const u16*)((char*)p.out + OFF_Z0T) : (const u16*)((char*)p.out + OFF_Z1T);
  const u16* urow = src + (long)c * NTOK + sb;
  const u16* gr = (const u16*)((char*)p.out + (samp ? OFF_GRS : OFF_GRP)) + (long)(order * 512 + c) * (samp ? LG_S : LG_P);
  const u16* g0 = gr + (L + 32 - t);
  float y = 0.f;
  for (int s = 0; s < L; ++s) y += bf2f(g0[s]) * bf2f(urow[s]);
  float gate = shortconv_at(p, 512 * (order + 1) + c, tok);
  float dv = p.hyd[order * 512 + c];
  float r = gate * (y + dv * bf2f(urow[t]));
  u16* dst = (order == 0) ? (u16*)((char*)p.out + OFF_Z1T) : (u16*)(p.ws + OFF_Z2T);
  dst[(long)c * NTOK + tok] = f2bf(r);
}

__global__ void __launch_bounds__(256) n_outproj(Params p) {
  long gid = (long)blockIdx.x * 256 + threadIdx.x;
  int col = (int)(gid & 1023), tok = (int)(gid >> 10);
  const u16* a = (const u16*)(p.ws + OFF_MIXED) + (long)tok * 1024;
  const u16* wb = (const u16*)(p.ws + OFF_WBOUT) + (long)col * 1024;
  float acc = 0.f;
  for (int k = 0; k < 1024; k += 8) {
    uint4 x = *(const uint4*)(a + k), b = *(const uint4*)(wb + k);
    acc += bflo(x.x) * bflo(b.x) + bfhi(x.x) * bfhi(b.x) + bflo(x.y) * bflo(b.y) + bfhi(x.y) * bfhi(b.y)
         + bflo(x.z) * bflo(b.z) + bfhi(x.z) * bfhi(b.z) + bflo(x.w) * bflo(b.w) + bfhi(x.w) * bfhi(b.w);
  }
  const float* xr = (tok < 32768) ? (p.x0 + (long)tok * 1024) : (p.x1 + (long)(tok - 32768) * 1024);
  p.out[(long)tok * 1024 + col] = 1.189207115002721f * xr[col] + acc;
}

__device__ __forceinline__ float wave_sum(float v) {
#pragma unroll
  for (int o = 32; o; o >>= 1) v += __shfl_xor(v, o);
  return v;
}

__device__ __forceinline__ void mixed_row(const Params& p, int tok, int lane) {
  u16* mixed = (u16*)(p.ws + OFF_MIXED) + (long)tok * 1024;
  const u16* Gb = (const u16*)(p.ws + OFF_GB) + (long)tok * 1024;
  {
    uint4 a = *(const uint4*)((const u16*)(p.ws + OFF_QB) + (long)tok * 512 + lane * 8);
    float v[8] = {bflo(a.x), bfhi(a.x), bflo(a.y), bfhi(a.y), bflo(a.z), bfhi(a.z), bflo(a.w), bfhi(a.w)};
    float ssq = 0.f;
#pragma unroll
    for (int j = 0; j < 8; ++j) ssq += v[j] * v[j];
    ssq = wave_sum(ssq);
    float r = rsqrtf(ssq * (1.f / 512.f) + 1e-6f);
    uint4 g = *(const uint4*)(Gb + lane * 8);
    float sg[8] = {bflo(g.x), bfhi(g.x), bflo(g.y), bfhi(g.y), bflo(g.z), bfhi(g.z), bflo(g.w), bfhi(g.w)};
    float4 n0 = *(const float4*)(p.gna + lane * 8), n1 = *(const float4*)(p.gna + lane * 8 + 4);
    float gn[8] = {n0.x, n0.y, n0.z, n0.w, n1.x, n1.y, n1.z, n1.w};
    float o[8];
#pragma unroll
    for (int j = 0; j < 8; ++j) o[j] = v[j] * r * gn[j] * sg[j];
    uint4 w; w.x = pack2(o[0], o[1]); w.y = pack2(o[2], o[3]); w.z = pack2(o[4], o[5]); w.w = pack2(o[6], o[7]);
    *(uint4*)(mixed + lane * 8) = w;
  }
}

#define ZSTR 272
__device__ __forceinline__ void mixed_hyena_128(const Params& p, int tok0, char* smem) {
  int tid_o = threadIdx.x; asm volatile("" : "+v"(tid_o));
  const int tid = tid_o;
  const u16* z2 = (const u16*)(p.ws + OFF_Z2T);
  float* ssq = (float*)(smem + 512 * ZSTR);
  __syncthreads();
#pragma unroll 4
  for (int it = 0; it < 16; ++it) {
    int id = it * 512 + tid; int row = id >> 4, part = id & 15;
    *(uint4*)(smem + row * ZSTR + part * 16) = *(const uint4*)(z2 + (long)row * NTOK + tok0 + part * 8);
  }
  __syncthreads();
  const int tk = tid & 127, cg = tid >> 7;
  const char* zc = smem + (cg * 128) * ZSTR + tk * 2;
  float acc = 0.f;
#pragma unroll 8
  for (int c = 0; c < 128; ++c) { float v = bf2f(*(const u16*)(zc + c * ZSTR)); acc += v * v; }
  ssq[cg * 128 + tk] = acc;
  __syncthreads();
  const float tot = ssq[tk] + ssq[128 + tk] + ssq[256 + tk] + ssq[384 + tk];
  const float r = rsqrtf(tot * (1.f / 512.f) + 1e-6f);
  const int tok = tok0 + tk;
  const u16* Gb = (const u16*)(p.ws + OFF_GB) + (long)tok * 1024 + 512 + cg * 128;
  u16* mixed = (u16*)(p.ws + OFF_MIXED) + (long)tok * 1024 + 512 + cg * 128;
  const float* gn = p.gnh + cg * 128;
#pragma unroll 8
  for (int i = 0; i < 16; ++i) {
    uint4 g = *(const uint4*)(Gb + i * 8);
    float sg[8] = {bflo(g.x), bfhi(g.x), bflo(g.y), bfhi(g.y), bflo(g.z), bfhi(g.z), bflo(g.w), bfhi(g.w)};
    float o[8];
#pragma unroll
    for (int j = 0; j < 8; ++j) o[j] = bf2f(*(const u16*)(zc + (i * 8 + j) * ZSTR)) * r * gn[i * 8 + j] * sg[j];
    uint4 wv; wv.x = pack2(o[0], o[1]); wv.y = pack2(o[2], o[3]); wv.z = pack2(o[4], o[5]); wv.w = pack2(o[6], o[7]);
    *(uint4*)(mixed + i * 8) = wv;
  }
}

__device__ __forceinline__ void ln_row(const Params& p, int tok, int lane) {
  float* row = p.out + (long)tok * 1024;
  float4 v[4];
  float s = 0.f;
#pragma unroll
  for (int q = 0; q < 4; ++q) { v[q] = *(const float4*)(row + q * 256 + lane * 4); s += v[q].x + v[q].y + v[q].z + v[q].w; }
  s = wave_sum(s);
  float mu = s * (1.f / 1024.f);
  float ss = 0.f;
#pragma unroll
  for (int q = 0; q < 4; ++q) {
    float a = v[q].x - mu, b = v[q].y - mu, c = v[q].z - mu, d = v[q].w - mu;
    ss += a * a + b * b + c * c + d * d;
  }
  ss = wave_sum(ss);
  float rstd = rsqrtf(ss * (1.f / 1024.f) + 1e-5f);
#pragma unroll
  for (int q = 0; q < 4; ++q) {
    float4 g = *(const float4*)(p.lng + q * 256 + lane * 4), b = *(const float4*)(p.lnb + q * 256 + lane * 4);
    float4 o;
    o.x = (v[q].x - mu) * rstd * g.x + b.x; o.y = (v[q].y - mu) * rstd * g.y + b.y;
    o.z = (v[q].z - mu) * rstd * g.z + b.z; o.w = (v[q].w - mu) * rstd * g.w + b.w;
    *(float4*)(row + q * 256 + lane * 4) = o;
  }
}


__device__ __forceinline__ void ln_row16(const Params& p, int tok, int lane) {
  const u16* hrow = (const u16*)(p.ws + OFF_GB) + (long)tok * 1024;
  float* orow = p.out + (long)tok * 1024;
  const float* xrow = (tok < 32768) ? (p.x0 + (long)tok * 1024) : (p.x1 + (long)(tok - 32768) * 1024);
  const float alpha = 1.189207115002721f;
  float v[16];
  float s = 0.f;
#pragma unroll
  for (int q = 0; q < 2; ++q) {
    uint4 a = *(const uint4*)(hrow + q * 512 + lane * 8);
    v[8 * q + 0] = bflo(a.x); v[8 * q + 1] = bfhi(a.x); v[8 * q + 2] = bflo(a.y); v[8 * q + 3] = bfhi(a.y);
    v[8 * q + 4] = bflo(a.z); v[8 * q + 5] = bfhi(a.z); v[8 * q + 6] = bflo(a.w); v[8 * q + 7] = bfhi(a.w);
    const float4 x0v = *(const float4*)(xrow + q * 512 + lane * 8), x1v = *(const float4*)(xrow + q * 512 + lane * 8 + 4);
    v[8 * q + 0] += alpha * x0v.x; v[8 * q + 1] += alpha * x0v.y; v[8 * q + 2] += alpha * x0v.z; v[8 * q + 3] += alpha * x0v.w;
    v[8 * q + 4] += alpha * x1v.x; v[8 * q + 5] += alpha * x1v.y; v[8 * q + 6] += alpha * x1v.z; v[8 * q + 7] += alpha * x1v.w;
  }
#pragma unroll
  for (int j = 0; j < 16; ++j) s += v[j];
  s = wave_sum(s);
  const float mu = s * (1.f / 1024.f);
  float ss = 0.f;
#pragma unroll
  for (int j = 0; j < 16; ++j) { float d = v[j] - mu; ss += d * d; }
  ss = wave_sum(ss);
  const float rstd = rsqrtf(ss * (1.f / 1024.f) + 1e-5f);
#pragma unroll
  for (int q = 0; q < 2; ++q)
#pragma unroll
    for (int hh = 0; hh < 2; ++hh) {
      const int c = q * 512 + lane * 8 + hh * 4;
      float4 g = *(const float4*)(p.lng + c), b = *(const float4*)(p.lnb + c);
      float4 o;
      o.x = (v[8 * q + 4 * hh + 0] - mu) * rstd * g.x + b.x; o.y = (v[8 * q + 4 * hh + 1] - mu) * rstd * g.y + b.y;
      o.z = (v[8 * q + 4 * hh + 2] - mu) * rstd * g.z + b.z; o.w = (v[8 * q + 4 * hh + 3] - mu) * rstd * g.w + b.w;
      *(float4*)(orow + c) = o;
    }
}

__global__ void __launch_bounds__(512) k_ln(Params p) {
  int tok = blockIdx.x * 8 + (threadIdx.x >> 6);
  ln_row(p, tok, threadIdx.x & 63);
}

#define LDSROW 144
#define TILEB (256 * LDSROW)
#define GEMM_LDS (4 * TILEB)

template <class Epi>
__device__ __forceinline__ void gemm_tile(const u16* __restrict__ A, long lda, const u16* __restrict__ B, long ldb,
                                          int K, char* smem, Epi& epi) {
  const int tid = threadIdx.x, lane = tid & 63, w = tid >> 6, wm = w >> 2, wn = w & 3;
  const int l31 = lane & 31, h = lane >> 5;
  f32x16 acc[4][2];
#pragma unroll
  for (int mi = 0; mi < 4; ++mi)
#pragma unroll
    for (int ni = 0; ni < 2; ++ni)
#pragma unroll
      for (int j = 0; j < 16; ++j) acc[mi][ni][j] = 0.f;
  uint4 ra0, ra1, ra2, ra3, rb0, rb1, rb2, rb3;
  const int srow = tid >> 3, skc = tid & 7;
  const u16* Ag = A + (long)srow * lda + skc * 8;
  const u16* Bg = B + (long)srow * ldb + skc * 8;
  const int soff = srow * LDSROW + skc * 16;
  const int nk = K >> 6;
#define GLD(kk) do { \
    ra0 = *(const uint4*)(Ag + (kk)); ra1 = *(const uint4*)(Ag + 64 * lda + (kk)); ra2 = *(const uint4*)(Ag + 128 * lda + (kk)); ra3 = *(const uint4*)(Ag + 192 * lda + (kk)); \
    rb0 = *(const uint4*)(Bg + (kk)); rb1 = *(const uint4*)(Bg + 64 * ldb + (kk)); rb2 = *(const uint4*)(Bg + 128 * ldb + (kk)); rb3 = *(const uint4*)(Bg + 192 * ldb + (kk)); } while (0)
#define SST(d) do { \
    *(uint4*)((d) + soff) = ra0; *(uint4*)((d) + soff + 64 * LDSROW) = ra1; *(uint4*)((d) + soff + 128 * LDSROW) = ra2; *(uint4*)((d) + soff + 192 * LDSROW) = ra3; \
    *(uint4*)((d) + TILEB + soff) = rb0; *(uint4*)((d) + TILEB + soff + 64 * LDSROW) = rb1; *(uint4*)((d) + TILEB + soff + 128 * LDSROW) = rb2; *(uint4*)((d) + TILEB + soff + 192 * LDSROW) = rb3; } while (0)
  GLD(0);
  __syncthreads();
  SST(smem);
  __syncthreads();
  for (int kt = 0; kt < nk; ++kt) {
    if (kt + 1 < nk) GLD((kt + 1) * 64);
    const char* a = smem + (kt & 1) * 2 * TILEB;
    const char* b = a + TILEB;
#pragma unroll 2
    for (int ks = 0; ks < 4; ++ks) {
      bf16x8 af[4], bfr[2];
#pragma unroll
      for (int mi = 0; mi < 4; ++mi) af[mi] = *(const bf16x8*)(a + (wm * 128 + mi * 32 + l31) * LDSROW + ks * 32 + h * 16);
#pragma unroll
      for (int ni = 0; ni < 2; ++ni) bfr[ni] = *(const bf16x8*)(b + (wn * 64 + ni * 32 + l31) * LDSROW + ks * 32 + h * 16);
#pragma unroll
      for (int mi = 0; mi < 4; ++mi)
#pragma unroll
        for (int ni = 0; ni < 2; ++ni)
          acc[mi][ni] = __builtin_amdgcn_mfma_f32_32x32x16_bf16(af[mi], bfr[ni], acc[mi][ni], 0, 0, 0);
    }
    if (kt + 1 < nk) {
      char* d = smem + ((kt + 1) & 1) * 2 * TILEB;
      SST(d);
    }
    __syncthreads();
  }
#pragma unroll
  for (int mi = 0; mi < 4; ++mi)
#pragma unroll
    for (int ni = 0; ni < 2; ++ni)
#pragma unroll
      for (int g = 0; g < 4; ++g)
        epi(wm * 128 + mi * 32 + 8 * g + 4 * h, wn * 64 + ni * 32 + l31,
            acc[mi][ni][4 * g], acc[mi][ni][4 * g + 1], acc[mi][ni][4 * g + 2], acc[mi][ni][4 * g + 3]);
}

struct EpiTokMajor {
  char* ws; int nt; int tok0;
  __device__ __forceinline__ void operator()(int m, int n, float v0, float v1, float v2, float v3) const {
    int tok = tok0 + n;
    int col = nt * 256 + m;
    u16* dst;
    if (col < 512) { dst = (u16*)(ws + OFF_QB) + (long)tok * 512 + col; v0 *= QSCALE; v1 *= QSCALE; v2 *= QSCALE; v3 *= QSCALE; }
    else if (col < 1024) dst = (u16*)(ws + OFF_KB) + (long)tok * 512 + (col - 512);
    else if (col < 1536) dst = (u16*)(ws + OFF_VB) + (long)tok * 512 + (col - 1024);
    else {
      int gc = (col < 2048) ? (col - 1536) : (512 + col - 3584);
      dst = (u16*)(ws + OFF_GB) + (long)tok * 1024 + gc;
      v0 = silu_f(v0); v1 = silu_f(v1); v2 = silu_f(v2); v3 = silu_f(v3);
    }
    uint2 o; o.x = pack2(v0, v1); o.y = pack2(v2, v3);
    *(uint2*)dst = o;
  }
};
struct EpiChanMajor {
  char* ws; int ch0; int tok0;
  __device__ __forceinline__ void operator()(int m, int n, float v0, float v1, float v2, float v3) const {
    u16* dst = (u16*)(ws + OFF_UT) + (long)(ch0 + n) * NTOK + tok0 + m;
    uint2 o; o.x = pack2(v0, v1); o.y = pack2(v2, v3);
    *(uint2*)dst = o;
  }
};

__device__ void phase1(const Params& p, char* smem) {
  const u16* xb = (const u16*)((char*)p.out + OFF_XB);
  const u16* wb = (const u16*)((char*)p.out + OFF_WBIN);
  for (int mt = blockIdx.x; mt < 256; mt += gridDim.x) {
    const int tok0 = mt * 256;
    for (int nt = 0; nt < 16; ++nt) {
      if (nt >= 8 && nt < 14) {
        EpiChanMajor e{p.ws, (nt - 8) * 256, tok0};
        gemm_tile(xb + (long)tok0 * 1024, 1024, wb + (long)nt * 256 * 1024, 1024, 1024, smem, e);
      } else {
        EpiTokMajor e{p.ws, nt, tok0};
        gemm_tile(wb + (long)nt * 256 * 1024, 1024, xb + (long)tok0 * 1024, 1024, 1024, smem, e);
      }
    }
  }
}
__global__ void __launch_bounds__(512) k_phase1(Params p) {
  extern __shared__ __attribute__((aligned(16))) char smem[];
  phase1(p, smem);
}

struct EpiOut {
  const float* x0; const float* x1; float* out; int ct; int tok0;
  __device__ __forceinline__ void operator()(int m, int n, float v0, float v1, float v2, float v3) const {
    int tok = tok0 + n, col = ct * 256 + m;
    const float* xr = (tok < 32768) ? (x0 + (long)tok * 1024) : (x1 + (long)(tok - 32768) * 1024);
    float4 xv = *(const float4*)(xr + col);
    const float alpha = 1.189207115002721f;
    float4 o; o.x = alpha * xv.x + v0; o.y = alpha * xv.y + v1; o.z = alpha * xv.z + v2; o.w = alpha * xv.w + v3;
    *(float4*)(out + (long)tok * 1024 + col) = o;
  }
};

__device__ void phase4(const Params& p, char* smem) {
  const u16* mixed = (const u16*)(p.ws + OFF_MIXED);
  const u16* wb = (const u16*)(p.ws + OFF_WBOUT);
  const int lane = threadIdx.x & 63, w = threadIdx.x >> 6;
  for (int mt = blockIdx.x; mt < 256; mt += gridDim.x) {
    const int tok0 = mt * 256;
    mixed_hyena_128(p, tok0, smem);
    mixed_hyena_128(p, tok0 + 128, smem);
    for (int i = 0; i < 32; ++i) mixed_row(p, tok0 + w * 32 + i, lane);
    __syncthreads();
    for (int ct = 0; ct < 4; ++ct) {
      EpiOut e{p.x0, p.x1, p.out, ct, tok0};
      gemm_tile(wb + (long)ct * 256 * 1024, 1024, mixed + (long)tok0 * 1024, 1024, 1024, smem, e);
    }
    __syncthreads();
    for (int i = 0; i < 32; ++i) ln_row(p, tok0 + w * 32 + i, lane);
  }
}
__global__ void __launch_bounds__(512) k_phase4(Params p) {
  extern __shared__ __attribute__((aligned(16))) char smem[];
  phase4(p, smem);
}

namespace pg8 {
#define PG8_LAS __attribute__((address_space(3)))
typedef unsigned short bf16_t;
typedef short bf16x8 __attribute__((ext_vector_type(8)));
typedef float f32x4 __attribute__((ext_vector_type(4)));
typedef unsigned u32x4 __attribute__((ext_vector_type(4)));
constexpr int BM = 256, BK = 64, HALF = 128, HTB = HALF * BK * 2  , STAGE_BYTES = 8 * HTB, NXCD = 8, WGM = 8;

__host__ __device__ __forceinline__ int lds_byte(int r, int c) { const int st = (r >> 4) * 2 + (c >> 5), rr = r & 15, cc = c & 31, ob = rr * 64 + cc * 2; return st * 1024 + (ob ^ (((ob >> 9) & 1) << 5)); }
__host__ __device__ __forceinline__ void stage_rc(int b, int& R, int& C) { const int st = b / 1024, sb = b % 1024, swz = sb ^ (((sb >> 9) & 1) << 5); R = (st >> 1) * 16 + swz / 64; C = (st & 1) * 32 + (swz % 64) / 2; }
__host__ __device__ __forceinline__ int perm32(int rho) { const int n = rho >> 4, i = rho & 15; return 8 * (i >> 2) + 4 * n + (i & 3); }
struct Unit { int pm, pn; };
struct Gemm { const bf16_t* A; const bf16_t* Bt; int M, N, K; };
__device__ __forceinline__ unsigned cvt_pk_bf16(float lo, float hi) { unsigned r; asm volatile("v_cvt_pk_bf16_f32 %0, %1, %2" : "=v"(r) : "v"(lo), "v"(hi)); return r; }
template <class Epi, class Sched, bool STAMP = false>
__device__ __forceinline__ void gemm_phase(PG8_LAS unsigned char* lds, const Gemm g, const Sched& S, const Epi& E, unsigned long long* stamps) {
    int tid_o = threadIdx.x; asm volatile("" : "+v"(tid_o));
    const int tid = tid_o, wid = __builtin_amdgcn_readfirstlane(tid >> 6), lane = tid & 63, wr = wid >> 2, wc = wid & 3, fr = lane & 15, fq = lane >> 4;
    const int K = g.K, nt = K / BK;
    int ts_lo = 0, ts_hi = 0, nts = 0; const unsigned long long rt_entry = STAMP ? 0ull : 0ull;
#define PG8_STAMP() do { if (STAMP && wid == 0 && nts < 64) { const unsigned long long _c = 0ull; \
        ts_lo = (lane == nts) ? (int)(unsigned)_c : ts_lo; ts_hi = (lane == nts) ? (int)(unsigned)(_c >> 32) : ts_hi; ++nts; } } while (0)
    PG8_STAMP();
    unsigned voffA[2], voffB[2];
#pragma unroll
    for (int i = 0; i < 2; ++i) { int R, C; stage_rc(tid * 16 + i * 8192, R, C); const int Rb = Epi::PERM ? ((R & ~31) + perm32(R & 31)) : R;
        voffA[i] = (unsigned)(R * K + C) * 2u; voffB[i] = (unsigned)(Rb * K + C) * 2u; }
    const size_t kstep = (size_t)(BK * 2);
    const size_t hstep = (size_t)HALF * K * 2;
    const size_t tstep = 2 * hstep;
    const unsigned ldsw = (unsigned)wid * 1024u;
    const int aoff = lds_byte(wr * 64 + fr, fq * 8), boff = lds_byte(wc * 32 + fr, fq * 8);
#define PG8_SA(b, h) (((b) * 2 + (h)) * HTB)
#define PG8_SB(b, h) ((4 + (b) * 2 + (h)) * HTB)
#define PG8_STAGE(bufoff, gbase, voff) do { _Pragma("unroll") for (int _i = 0; _i < 2; ++_i) \
        __builtin_amdgcn_global_load_lds((const unsigned*)((const char*)(gbase) + (voff)[_i]), (PG8_LAS unsigned*)(lds + (bufoff) + ldsw + _i * 8192), 16, 0, 0); } while (0)
#define PG8_LDA(dst, b, h) do { _Pragma("unroll") for (int m = 0; m < 4; ++m) _Pragma("unroll") for (int k = 0; k < 2; ++k) dst[m][k] = *(const PG8_LAS bf16x8*)(lds + PG8_SA(b, h) + aoff + m * 2048 + k * 1024); } while (0)
#define PG8_LDB(dst, b, h) do { _Pragma("unroll") for (int n = 0; n < 2; ++n) _Pragma("unroll") for (int k = 0; k < 2; ++k) dst[n][k] = *(const PG8_LAS bf16x8*)(lds + PG8_SB(b, h) + boff + n * 2048 + k * 1024); } while (0)
#define PG8_MMA(ai, bj, At, Bt) do { __builtin_amdgcn_s_setprio(1); _Pragma("unroll") for (int m = 0; m < 4; ++m) _Pragma("unroll") for (int n = 0; n < 2; ++n) _Pragma("unroll") for (int k = 0; k < 2; ++k) \
        acc[ai][bj][m][n] = __builtin_amdgcn_mfma_f32_16x16x32_bf16(Bt[n][k], At[m][k], acc[ai][bj][m][n], 0, 0, 0); __builtin_amdgcn_s_setprio(0); } while (0)
#define PG8_WAIT_V(n) asm volatile("s_waitcnt vmcnt(" #n ")" ::: "memory")
#define PG8_WAIT_L(n) asm volatile("s_waitcnt lgkmcnt(" #n ")" ::: "memory")
#define PG8_BAR __builtin_amdgcn_s_barrier()
#define PG8_SCHED __builtin_amdgcn_sched_barrier(0)
    Unit cur, nxt; int ui = 0;
    if (!S.next(0, cur)) return;
    f32x4 acc[2][2][4][2];
#pragma unroll
    for (int a = 0; a < 2; ++a)
#pragma unroll
        for (int b = 0; b < 2; ++b)
#pragma unroll
            for (int m = 0; m < 4; ++m)
#pragma unroll
                for (int n = 0; n < 2; ++n) acc[a][b][m][n] = (f32x4){0.f, 0.f, 0.f, 0.f};
    bf16x8 At[4][2], B0[2][2], B1[2][2];
    const char* cA = (const char*)g.A + (size_t)cur.pm * tstep; const char* cB = (const char*)g.Bt + (size_t)cur.pn * tstep;
    S.a_ready(cur);
    PG8_STAGE(PG8_SB(0, 0), cB, voffB); PG8_STAGE(PG8_SA(0, 0), cA, voffA); PG8_STAGE(PG8_SB(0, 1), cB + hstep, voffB); PG8_STAGE(PG8_SA(0, 1), cA + hstep, voffA);
    if (wr == 1) PG8_BAR;
    PG8_WAIT_V(4); PG8_BAR;
    PG8_STAGE(PG8_SB(1, 0), cB + kstep, voffB); PG8_STAGE(PG8_SA(1, 0), cA + kstep, voffA); PG8_STAGE(PG8_SB(1, 1), cB + hstep + kstep, voffB);
    PG8_WAIT_V(6); PG8_BAR;
    PG8_STAMP();
    for (;;) {
        const bool has_next = S.next(ui + 1, nxt);
        const char* nA = has_next ? (const char*)g.A + (size_t)nxt.pm * tstep : cA; const char* nB = has_next ? (const char*)g.Bt + (size_t)nxt.pn * tstep : cB;
        for (int t = 0; t < nt; t += 2) {
            const bool last = (t == nt - 2);
            const char* a1 = cA + (size_t)(t + 1) * kstep;
            const char* a2 = last ? nA : cA + (size_t)(t + 2) * kstep; const char* b2 = last ? nB : cB + (size_t)(t + 2) * kstep;
            const char* a3 = a2 + kstep; const char* b3 = b2 + kstep;
            if (last && has_next) S.a_ready(nxt);
            PG8_LDB(B0, 0, 0); PG8_SCHED; PG8_LDA(At, 0, 0); PG8_STAGE(PG8_SA(1, 1), a1 + hstep, voffA);
            PG8_WAIT_L(8); PG8_BAR; PG8_WAIT_L(0); PG8_MMA(0, 0, At, B0); PG8_BAR; PG8_SCHED;
            PG8_LDB(B1, 0, 1); PG8_STAGE(PG8_SB(0, 0), b2, voffB);
            PG8_BAR; PG8_WAIT_L(0); PG8_MMA(0, 1, At, B1); PG8_BAR;
            PG8_LDA(At, 0, 1); PG8_STAGE(PG8_SA(0, 0), a2, voffA);
            PG8_BAR; PG8_WAIT_L(0); PG8_MMA(1, 0, At, B0); PG8_BAR; PG8_SCHED;
            PG8_STAGE(PG8_SB(0, 1), b2 + hstep, voffB);
            PG8_WAIT_V(6); PG8_BAR; PG8_MMA(1, 1, At, B1); PG8_BAR;
            PG8_LDB(B0, 1, 0); PG8_SCHED; PG8_LDA(At, 1, 0); PG8_STAGE(PG8_SA(0, 1), a2 + hstep, voffA);
            PG8_WAIT_L(8); PG8_BAR; PG8_WAIT_L(0); PG8_MMA(0, 0, At, B0); PG8_BAR; PG8_SCHED;
            PG8_LDB(B1, 1, 1); PG8_STAGE(PG8_SB(1, 0), b3, voffB);
            PG8_BAR; PG8_WAIT_L(0); PG8_MMA(0, 1, At, B1); PG8_BAR;
            PG8_LDA(At, 1, 1); PG8_STAGE(PG8_SA(1, 0), a3, voffA);
            PG8_BAR; PG8_WAIT_L(0); PG8_MMA(1, 0, At, B0); PG8_BAR; PG8_SCHED;
            PG8_STAGE(PG8_SB(1, 1), b3 + hstep, voffB);
            PG8_WAIT_V(6); PG8_BAR; PG8_MMA(1, 1, At, B1); PG8_BAR;
        }
        PG8_STAMP();
        if constexpr (!Epi::AFTER_DRAIN) { E(acc, cur, wr, wc, fr, fq); S.done(cur); }
        PG8_STAMP();
        if (!has_next) break;
#pragma unroll
        for (int a = 0; a < 2; ++a)
#pragma unroll
            for (int b = 0; b < 2; ++b)
#pragma unroll
                for (int m = 0; m < 4; ++m)
#pragma unroll
                    for (int n = 0; n < 2; ++n) acc[a][b][m][n] = (f32x4){0.f, 0.f, 0.f, 0.f};
        cur = nxt; cA = nA; cB = nB; ++ui;
    }
    PG8_WAIT_V(0);
    if (wr == 0) PG8_BAR;
    PG8_BAR;
    if constexpr (Epi::AFTER_DRAIN) { E.fused(acc, cur, wr, wc, fr, fq, lds, wid, lane); S.done(cur); }
    PG8_STAMP();
    if (STAMP && wid == 0) { stamps[lane] = lane < nts ? (((unsigned long long)(unsigned)ts_hi << 32) | (unsigned)ts_lo) : 0ull;
        if (lane == 62) stamps[62] = rt_entry; if (lane == 63) stamps[63] = 0ull; }
#undef PG8_STAMP
#undef PG8_SA
#undef PG8_SB
#undef PG8_STAGE
#undef PG8_LDA
#undef PG8_LDB
#undef PG8_MMA
#undef PG8_WAIT_V
#undef PG8_WAIT_L
#undef PG8_BAR
#undef PG8_SCHED
}
}

struct SchedRowTile {
  int pm; int n; int base; int skip_from; int skip_add;
  __device__ __forceinline__ bool next(int i, pg8::Unit& u) const { if (i >= n) return false; u.pm = pm; u.pn = base + i + (i >= skip_from ? skip_add : 0); return true; }
  __device__ __forceinline__ void a_ready(const pg8::Unit&) const {}
  __device__ __forceinline__ void done(const pg8::Unit&) const {}
};
struct SchedColTile {
  int pn; int n;
  __device__ __forceinline__ bool next(int i, pg8::Unit& u) const { if (i >= n) return false; u.pm = i; u.pn = pn; return true; }
  __device__ __forceinline__ void a_ready(const pg8::Unit&) const {}
  __device__ __forceinline__ void done(const pg8::Unit&) const {}
};


struct SchedXcd {
  int nM, nN, nwg, G, c, skip_from, skip_add;
  __device__ __forceinline__ bool next(int i, pg8::Unit& u) const {
    const long L = (long)i * G + c; if (L >= nwg) return false;
    int wgid = (int)L; { const int q = nwg / 8, r = nwg % 8, xcd = wgid % 8, off = wgid / 8; wgid = (xcd < r ? xcd * (q + 1) : r * (q + 1) + (xcd - r) * q) + off; }
    const int nig = 8 * nN, gid = wgid / nig, fm = gid * 8, gsz = (nM - fm) < 8 ? (nM - fm) : 8;
    u.pm = fm + ((wgid % nig) % gsz);
    const int pn = (wgid % nig) / gsz;
    u.pn = pn + (pn >= skip_from ? skip_add : 0);
    return true;
  }
  __device__ __forceinline__ void a_ready(const pg8::Unit&) const {}
  __device__ __forceinline__ void done(const pg8::Unit&) const {}
};

struct EpiProjTok {
  static constexpr bool PERM = true, AFTER_DRAIN = false;
  char* ws;
  __device__ __forceinline__ void operator()(const pg8::f32x4 (&acc)[2][2][4][2], const pg8::Unit& u, int wr, int wc, int fr, int fq) const {
    int row0 = u.pm * 256 + wr * 64 + fr;
    asm volatile("" : "+v"(row0));
    const int pn = u.pn;
    u16* base; int ldc; int cofs; int mode;
    if (pn < 2) { base = (u16*)(ws + OFF_QB); ldc = 512; cofs = pn * 256; mode = 1; }
    else if (pn < 4) { base = (u16*)(ws + OFF_KB); ldc = 512; cofs = (pn - 2) * 256; mode = 0; }
    else if (pn < 6) { base = (u16*)(ws + OFF_VB); ldc = 512; cofs = (pn - 4) * 256; mode = 0; }
    else if (pn < 8) { base = (u16*)(ws + OFF_GB); ldc = 1024; cofs = (pn - 6) * 256; mode = 2; }
    else { base = (u16*)(ws + OFF_GB); ldc = 1024; cofs = 512 + (pn - 14) * 256; mode = 2; }
    const int col0 = cofs + wc * 32 + 8 * fq;
#pragma unroll
    for (int ai = 0; ai < 2; ++ai)
#pragma unroll
      for (int m = 0; m < 4; ++m) {
        u16* rowp = base + (size_t)(row0 + ai * 128 + m * 16) * ldc + col0;
#pragma unroll
        for (int bj = 0; bj < 2; ++bj) {
          pg8::f32x4 v0 = acc[ai][bj][m][0], v1 = acc[ai][bj][m][1];
          if (mode == 1) { v0 *= QSCALE; v1 *= QSCALE; }
          if (mode == 2) {
#pragma unroll
            for (int j = 0; j < 4; ++j) { v0[j] = silu_f(v0[j]); v1[j] = silu_f(v1[j]); }
          }
          pg8::u32x4 w; w.x = pg8::cvt_pk_bf16(v0[0], v0[1]); w.y = pg8::cvt_pk_bf16(v0[2], v0[3]); w.z = pg8::cvt_pk_bf16(v1[0], v1[1]); w.w = pg8::cvt_pk_bf16(v1[2], v1[3]);
          *(pg8::u32x4*)(rowp + bj * 128) = w;
        }
      }
  }
};
struct EpiProjChan {
  static constexpr bool PERM = true, AFTER_DRAIN = false;
  char* ws;
  __device__ __forceinline__ void operator()(const pg8::f32x4 (&acc)[2][2][4][2], const pg8::Unit& u, int wr, int wc, int fr, int fq) const {
    int row0 = u.pm * 256 + wr * 64 + fr;
    int col0 = u.pn * 256 + wc * 32 + 8 * fq;
    asm volatile("" : "+v"(row0), "+v"(col0));
    u16* base = (u16*)(ws + OFF_UT);
#pragma unroll
    for (int ai = 0; ai < 2; ++ai)
#pragma unroll
      for (int m = 0; m < 4; ++m) {
        u16* rowp = base + (size_t)(row0 + ai * 128 + m * 16) * NTOK + col0;
#pragma unroll
        for (int bj = 0; bj < 2; ++bj) {
          pg8::f32x4 v0 = acc[ai][bj][m][0], v1 = acc[ai][bj][m][1];
          pg8::u32x4 w; w.x = pg8::cvt_pk_bf16(v0[0], v0[1]); w.y = pg8::cvt_pk_bf16(v0[2], v0[3]); w.z = pg8::cvt_pk_bf16(v1[0], v1[1]); w.w = pg8::cvt_pk_bf16(v1[2], v1[3]);
          *(pg8::u32x4*)(rowp + bj * 128) = w;
        }
      }
  }
};
struct EpiOutF32 {
  static constexpr bool PERM = false, AFTER_DRAIN = false;
  const float* x0; const float* x1; float* out;
  __device__ __forceinline__ void operator()(const pg8::f32x4 (&acc)[2][2][4][2], const pg8::Unit& u, int wr, int wc, int fr, int fq) const {
    int row0 = u.pm * 256 + wr * 64 + fr, col0 = u.pn * 256 + wc * 32 + 4 * fq;
    asm volatile("" : "+v"(row0), "+v"(col0));
    const float alpha = 1.189207115002721f;
#pragma unroll
    for (int ai = 0; ai < 2; ++ai)
#pragma unroll
      for (int m = 0; m < 4; ++m) {
        const int tok = row0 + ai * 128 + m * 16;
        const float* xr = ((tok < 32768) ? (x0 + (size_t)tok * 1024) : (x1 + (size_t)(tok - 32768) * 1024)) + col0;
        float* rowp = out + (size_t)tok * 1024 + col0;
#pragma unroll
        for (int bj = 0; bj < 2; ++bj)
#pragma unroll
          for (int n = 0; n < 2; ++n) {
            pg8::f32x4 xv = *(const pg8::f32x4*)(xr + bj * 128 + n * 16);
            *(pg8::f32x4*)(rowp + bj * 128 + n * 16) = acc[ai][bj][m][n] + alpha * xv;
          }
        __builtin_amdgcn_sched_barrier(0);
      }
  }
};


struct EpiOutH16 {
  static constexpr bool PERM = true, AFTER_DRAIN = false;
  const float* x0; const float* x1; char* ws;
  __device__ __forceinline__ void operator()(const pg8::f32x4 (&acc)[2][2][4][2], const pg8::Unit& u, int wr, int wc, int fr, int fq) const {
    int row0 = u.pm * 256 + wr * 64 + fr, col0 = u.pn * 256 + wc * 32 + 8 * fq;
    asm volatile("" : "+v"(row0), "+v"(col0));
    u16* hb = (u16*)(ws + OFF_GB);
#pragma unroll
    for (int ai = 0; ai < 2; ++ai)
#pragma unroll
      for (int m = 0; m < 4; ++m) {
        const int tok = row0 + ai * 128 + m * 16;
        u16* rowp = hb + (size_t)tok * 1024 + col0;
#pragma unroll
        for (int bj = 0; bj < 2; ++bj) {
          pg8::f32x4 v0 = acc[ai][bj][m][0], v1 = acc[ai][bj][m][1];
          pg8::u32x4 w; w.x = pg8::cvt_pk_bf16(v0[0], v0[1]); w.y = pg8::cvt_pk_bf16(v0[2], v0[3]); w.z = pg8::cvt_pk_bf16(v1[0], v1[1]); w.w = pg8::cvt_pk_bf16(v1[2], v1[3]);
          *(pg8::u32x4*)(rowp + bj * 128) = w;
        }
        __builtin_amdgcn_sched_barrier(0);
      }
  }
};

__device__ __forceinline__ void phase1_v8(const Params& p, char* smem) {
  const pg8::bf16_t* xb = (const pg8::bf16_t*)((char*)p.out + OFF_XB);
  const pg8::bf16_t* wb = (const pg8::bf16_t*)((char*)p.out + OFF_WBIN);
  PG8_LAS unsigned char* lds = (PG8_LAS unsigned char*)smem;
  __syncthreads();
  {
    pg8::Gemm g{xb, wb, NTOK, 4096, 1024};
    SchedXcd S{256, 10, 2560, (int)gridDim.x, (int)blockIdx.x, 8, 6};
    EpiProjTok E{p.ws};
    pg8::gemm_phase<EpiProjTok, SchedXcd, false>(lds, g, S, E, nullptr);
  }
  __syncthreads();
  {
    pg8::Gemm g{wb + (size_t)2048 * 1024, xb, 1536, NTOK, 1024};
    SchedXcd S{6, 256, 1536, (int)gridDim.x, (int)blockIdx.x, 1 << 30, 0};
    EpiProjChan E{p.ws};
    pg8::gemm_phase<EpiProjChan, SchedXcd, false>(lds, g, S, E, nullptr);
  }
}

__device__ __forceinline__ void phase4_v8(const Params& p, char* smem) {
  const pg8::bf16_t* mixed = (const pg8::bf16_t*)(p.ws + OFF_MIXED);
  const pg8::bf16_t* wb = (const pg8::bf16_t*)g_wbout;
  PG8_LAS unsigned char* lds = (PG8_LAS unsigned char*)smem;
  const int lane = threadIdx.x & 63, w = threadIdx.x >> 6;
  for (int mt = blockIdx.x; mt < 256; mt += gridDim.x) {
    const int tok0 = mt * 256;
    mixed_hyena_128(p, tok0, smem);
    mixed_hyena_128(p, tok0 + 128, smem);
    { int lane1 = lane, w1 = w; asm volatile("" : "+v"(lane1), "+v"(w1));
      _Pragma("unroll 8") for (int i = 0; i < 32; ++i) mixed_row(p, tok0 + w1 * 32 + i, lane1); }
    __syncthreads();
    {
      pg8::Gemm g{mixed, wb, NTOK, 1024, 1024};
      SchedRowTile S{mt, 4, 0, 99, 0};
      EpiOutH16 E{p.x0, p.x1, p.ws};
      pg8::gemm_phase<EpiOutH16, SchedRowTile, false>(lds, g, S, E, nullptr);
    }
    __syncthreads();
    int lane2 = lane, w2 = w;
    asm volatile("" : "+v"(lane2), "+v"(w2));
#pragma unroll 8
    for (int i = 0; i < 32; ++i) ln_row16(p, tok0 + w2 * 32 + i, lane2);
  }
}

#define HY_US_BYTES 85760
#define HY_ZOFF 85760
#define HY_ZBYTES 5248
#define HY_GRL_OFF (HY_ZOFF + HY_ZBYTES)
#define HY_LDS (HY_GRL_OFF + 65664 + 64)
#define PHYS(x) ((x) + (((x) >> 5) << 3))

__device__ __forceinline__ uint4 conv8(const u16* __restrict__ row, int tau, int t, int L, float cb, float w0, float w1, float w2) {
  uint4 raw = *(const uint4*)(row + tau);
  float v[10];
  v[0] = (t > 0) ? bf2f(row[tau - 1]) : 0.f;
  v[1] = bflo(raw.x); v[2] = bfhi(raw.x); v[3] = bflo(raw.y); v[4] = bfhi(raw.y);
  v[5] = bflo(raw.z); v[6] = bfhi(raw.z); v[7] = bflo(raw.w); v[8] = bfhi(raw.w);
  v[9] = (t + 8 < L) ? bf2f(row[tau + 8]) : 0.f;
  float o[8];
#pragma unroll
  for (int j = 0; j < 8; ++j) o[j] = cb + w0 * v[j] + w1 * v[j + 1] + w2 * v[j + 2];
  uint4 r; r.x = pack2(o[0], o[1]); r.y = pack2(o[2], o[3]); r.z = pack2(o[4], o[5]); r.w = pack2(o[6], o[7]);
  return r;
}

template <bool SAMP>
__device__ __forceinline__ void hyena_unit(const Params& p, int c, char* smem) {
  constexpr int L = SAMP ? 16384 : 4096;
  constexpr int LSH = SAMP ? 14 : 12;
  constexpr int NB = SAMP ? 2 : 8;
  constexpr int P = SAMP ? 512 : 128;
  constexpr int LG = SAMP ? LG_S : LG_P;
  constexpr int BS = L + P;
  constexpr int TB = P * 5 / 2;
  constexpr int tokbase = SAMP ? 32768 : 0;
  const int tid = threadIdx.x, lane = tid & 63;
  const int w = __builtin_amdgcn_readfirstlane(tid >> 6);
  u16* us = (u16*)smem;
  u16* grl = (u16*)(smem + HY_GRL_OFF);
  const u16* UT = (const u16*)(p.ws + OFF_UT);
  constexpr int NF = (LG / 8 + 511) / 512;
  uint4 fr[NF];
#pragma unroll
  for (int k = 0; k < NF; ++k) fr[k] = make_uint4(0, 0, 0, 0);
#pragma unroll 1
  for (int order = 0; order < 2; ++order) {
  const u16* GRg = (const u16*)((char*)p.out + (SAMP ? OFF_GRS : OFF_GRP)) + (long)(order * 512 + c) * LG;
  const u16* usrc = (order == 0) ? (UT + (long)c * NTOK + tokbase)
                                 : ((const u16*)((char*)p.out + OFF_Z1T) + (long)c * NTOK + tokbase);
  const int gch = 512 * (order + 1) + c;
  const u16* gsrc = UT + (long)gch * NTOK + tokbase;
  u16* dst = ((order == 0) ? (u16*)((char*)p.out + OFF_Z1T) : (u16*)(p.ws + OFF_Z2T)) + (long)c * NTOK + tokbase;

  __syncthreads();
  if (order == 0) {
#pragma unroll
    for (int k = 0; k < NF; ++k) { int i = tid + k * 512; if (i < LG / 8) *(uint4*)(grl + i * 8) = *(const uint4*)(GRg + i * 8); }
  } else {
#pragma unroll
    for (int k = 0; k < NF; ++k) { int i = tid + k * 512; if (i < LG / 8) *(uint4*)(grl + i * 8) = fr[k]; }
  }
  if (tid < 4) *(uint4*)(grl + LG + tid * 8) = make_uint4(0, 0, 0, 0);
  if (order == 0) {
  {
    const uint4 z4 = make_uint4(0, 0, 0, 0);
    for (int i = tid; i < HY_ZBYTES / 16; i += 512) *(uint4*)(smem + HY_ZOFF + i * 16) = z4;
    for (int i = tid; i < (P >> 3); i += 512) { int x = i * 8; *(uint4*)(us + PHYS(x)) = z4; }
    for (int i = tid; i < NB * (P >> 3); i += 512) {
      int g = i / (P >> 3), r = i - g * (P >> 3);
      int x = P + g * BS + L + r * 8;
      *(uint4*)(us + PHYS(x)) = z4;
    }
  }
  {
    const float cb = p.conv_b[c], w0 = p.conv_w[c], w1 = p.conv_w[1536 + c], w2 = p.conv_w[3072 + c];
#pragma unroll
    for (int k = 0; k < 8; ++k) {
      int i = tid + k * 512;
      int tau = i * 8, b = tau >> LSH, t = tau & (L - 1);
      int x = P + b * BS + t;
      *(uint4*)(us + PHYS(x)) = conv8(usrc, tau, t, L, cb, w0, w1, w2);
    }
  }
  }
  __syncthreads();

  int lane_o = lane; asm volatile("" : "+v"(lane_o));
  const int n = lane_o & 31, h = lane_o >> 5;
  int grp, idx;
  if (n < 4) { grp = 0; idx = n; } else if (n < 12) { grp = 1; idx = n - 4; } else if (n < 16) { grp = 0; idx = n - 8; }
  else if (n < 20) { grp = 1; idx = n - 8; } else if (n < 28) { grp = 0; idx = n - 12; } else { grp = 1; idx = n - 16; }
  const int bat = SAMP ? grp : (4 * grp + (idx & 3));
  const int ii = SAMP ? idx : (idx >> 2);
  const int ebase = L + 32 - n + 8 * h;
  const unsigned sh = (unsigned)(ebase & 1) * 16u;
  f32x16 acc0, acc1, acc2, acc3;
#pragma unroll
  for (int j = 0; j < 16; ++j) { acc0[j] = 0.f; acc1[j] = 0.f; acc2[j] = 0.f; acc3[j] = 0.f; }
  const int o0 = P * 4 * w;
  const int base_hi = o0 + 4 * P - 32;
  constexpr int JN2 = P / 32;
  constexpr int NI = (L + 4 * P - 32) / 16;
  constexpr int KB = (NI + 2 * (P / 16) - 1) / (2 * (P / 16));
  constexpr int NPAIR = KB * JN2;
  constexpr int smin = -(P - 32), smaxp = L - 32;
  const int a_lane = HY_GRL_OFF + ((ebase >> 1) << 2);
  const int a_lane8 = a_lane - 2 * base_hi;
  const int b_lane = 2 * (8 * h + 40 * ii + bat * (BS * 5 / 4)) + 2 * ((-3 * P + 32) * 5 / 4);
  const int vz = HY_ZOFF;

#define HY_LD(SFX, VA, E0, E1, E2, E3, E4, IMM) do { \
    const unsigned* ga_ = (const unsigned*)(smem + (VA) + (IMM)); \
    const unsigned* gb_ = (const unsigned*)(smem + (VA) + 2 * P + (IMM)); \
    pa0##SFX = ga_[0]; pa1##SFX = ga_[1]; pa2##SFX = ga_[2]; pa3##SFX = ga_[3]; pa4##SFX = ga_[4]; \
    pb0##SFX = gb_[0]; pb1##SFX = gb_[1]; pb2##SFX = gb_[2]; pb3##SFX = gb_[3]; pb4##SFX = gb_[4]; \
    b0##SFX = *(const bf16x8*)(smem + (E0) + (IMM)); \
    b1##SFX = *(const bf16x8*)(smem + (E1) + TB + (IMM)); \
    b2##SFX = *(const bf16x8*)(smem + (E2) + 2 * TB + (IMM)); \
    b3##SFX = *(const bf16x8*)(smem + (E3) + 3 * TB + (IMM)); \
    b4##SFX = *(const bf16x8*)(smem + (E4) + 4 * TB + (IMM)); } while (0)
#define HY_AFRAG(DST, D0, D1, D2, D3, D4) do { \
    DST.u[0] = __builtin_amdgcn_alignbit(D1, D0, sh); DST.u[1] = __builtin_amdgcn_alignbit(D2, D1, sh); \
    DST.u[2] = __builtin_amdgcn_alignbit(D3, D2, sh); DST.u[3] = __builtin_amdgcn_alignbit(D4, D3, sh); } while (0)
#define HY_MMA(SFX) do { \
    union { unsigned u[4]; bf16x8 v; } Aa_, Ab_; \
    HY_AFRAG(Aa_, pa0##SFX, pa1##SFX, pa2##SFX, pa3##SFX, pa4##SFX); \
    HY_AFRAG(Ab_, pb0##SFX, pb1##SFX, pb2##SFX, pb3##SFX, pb4##SFX); \
    acc0 = __builtin_amdgcn_mfma_f32_32x32x16_bf16(Aa_.v, b0##SFX, acc0, 0, 0, 0); \
    acc1 = __builtin_amdgcn_mfma_f32_32x32x16_bf16(Aa_.v, b1##SFX, acc1, 0, 0, 0); \
    acc2 = __builtin_amdgcn_mfma_f32_32x32x16_bf16(Aa_.v, b2##SFX, acc2, 0, 0, 0); \
    acc3 = __builtin_amdgcn_mfma_f32_32x32x16_bf16(Aa_.v, b3##SFX, acc3, 0, 0, 0); \
    acc0 = __builtin_amdgcn_mfma_f32_32x32x16_bf16(Ab_.v, b1##SFX, acc0, 0, 0, 0); \
    acc1 = __builtin_amdgcn_mfma_f32_32x32x16_bf16(Ab_.v, b2##SFX, acc1, 0, 0, 0); \
    acc2 = __builtin_amdgcn_mfma_f32_32x32x16_bf16(Ab_.v, b3##SFX, acc2, 0, 0, 0); \
    acc3 = __builtin_amdgcn_mfma_f32_32x32x16_bf16(Ab_.v, b4##SFX, acc3, 0, 0, 0); } while (0)
#define HY_ADDR(K, JP) do { \
    const int sc_ = 4 * P * (K) + 64 * (JP); \
    va = a_lane8 + ((K) < KB ? sc_ : 0); \
    vb = b_lane + 5 * P * (K) + 80 * (JP); \
    const int s_ = -4 * P + 32 + 2 * P * (K) + 32 * (JP); \
    const bool ok_ = (K) < KB; \
    e0 = (ok_ && s_ >= smin && s_ <= smaxp) ? vb : vz; \
    e1 = (ok_ && s_ + P >= smin && s_ + P <= smaxp) ? vb : vz; \
    e2 = (ok_ && s_ + 2 * P >= smin && s_ + 2 * P <= smaxp) ? vb : vz; \
    e3 = (ok_ && s_ + 3 * P >= smin && s_ + 3 * P <= smaxp) ? vb : vz; \
    e4 = (ok_ && s_ + 4 * P >= smin && s_ + 4 * P <= smaxp) ? vb : vz; } while (0)
  {
    unsigned pa0x, pa1x, pa2x, pa3x, pa4x, pb0x, pb1x, pb2x, pb3x, pb4x, pa0y, pa1y, pa2y, pa3y, pa4y, pb0y, pb1y, pb2y, pb3y, pb4y,
             pa0z, pa1z, pa2z, pa3z, pa4z, pb0z, pb1z, pb2z, pb3z, pb4z;
    bf16x8 b0x, b1x, b2x, b3x, b4x, b0y, b1y, b2y, b3y, b4y, b0z, b1z, b2z, b3z, b4z;
    int va, vb, e0, e1, e2, e3, e4;
    int k = 0, jp = 0;
    static_assert(NPAIR % 3 == 0, "three rotating register sets");
#define HY_NEXTPAIR() do { jp += 1; if (jp == JN2) { jp = 0; k += 1; } HY_ADDR(k, jp); } while (0)
#define HY_STEP(CUR, TGT, IMM) do { \
      __builtin_amdgcn_sched_barrier(0); \
      HY_MMA(CUR); \
      __builtin_amdgcn_sched_barrier(0); \
      HY_LD(TGT, va, e0, e1, e2, e3, e4, IMM); } while (0)
    HY_ADDR(k, jp);
    HY_LD(x, va, e0, e1, e2, e3, e4, 0);
    HY_LD(y, va, e0, e1, e2, e3, e4, 32);
    for (int it = 0; it < NPAIR / 3; ++it) {
      HY_NEXTPAIR();
      HY_STEP(x, z, 0);
      HY_STEP(y, x, 32);
      HY_NEXTPAIR();
      HY_STEP(z, y, 0);
      HY_STEP(x, z, 32);
      HY_NEXTPAIR();
      HY_STEP(y, x, 0);
      HY_STEP(z, y, 32);
    }
  }
  __syncthreads();
  if (order == 0) {
    const u16* GRn = GRg + (long)512 * LG;
#pragma unroll
    for (int k = 0; k < NF; ++k) { int i = tid + k * 512; if (i < LG / 8) fr[k] = *(const uint4*)(GRn + i * 8); }
  }
  {
    const float cb = p.conv_b[gch], w0 = p.conv_w[gch], w1 = p.conv_w[1536 + gch], w2 = p.conv_w[3072 + gch];
#pragma unroll
    for (int k = 0; k < 8; ++k) {
      int i = tid + k * 512;
      int tau = i * 8, t = tau & (L - 1);
      *(uint4*)(grl + tau) = conv8(gsrc, tau, t, L, cb, w0, w1, w2);
    }
  }
  __syncthreads();
  const float dv = p.hyd[order * 512 + c];
#define HY_EPI(ACC, R) do { \
    _Pragma("unroll") for (int g4 = 0; g4 < 4; ++g4) { \
      int t = o0 + P * (R) + 8 * g4 + 4 * h + 32 * ii; \
      int tau = (bat << LSH) + t; \
      int ue_ = P + bat * BS + t; \
      uint2 uu = *(const uint2*)(us + PHYS(ue_)); \
      uint2 gg = *(const uint2*)(grl + tau); \
      float y0 = bflo(gg.x) * (ACC[4 * g4 + 0] + dv * bflo(uu.x)); \
      float y1 = bfhi(gg.x) * (ACC[4 * g4 + 1] + dv * bfhi(uu.x)); \
      float y2 = bflo(gg.y) * (ACC[4 * g4 + 2] + dv * bflo(uu.y)); \
      float y3 = bfhi(gg.y) * (ACC[4 * g4 + 3] + dv * bfhi(uu.y)); \
      uint2 oo; oo.x = pack2(y0, y1); oo.y = pack2(y2, y3); \
      if (order == 0) *(uint2*)(us + PHYS(ue_)) = oo; else *(uint2*)(dst + tau) = oo; \
    } } while (0)
  HY_EPI(acc0, 0); HY_EPI(acc1, 1); HY_EPI(acc2, 2); HY_EPI(acc3, 3);
  }
}

__device__ __forceinline__ void hyena_phase(const Params& p, char* smem) {
  for (int b = blockIdx.x; b < 256; b += gridDim.x) {
#pragma unroll 1
    for (int u = 0; u < 2; ++u) hyena_unit<true>(p, b + 256 * u, smem);
#pragma unroll 1
    for (int u = 0; u < 2; ++u) hyena_unit<false>(p, b + 256 * u, smem);
  }
}
__global__ void __launch_bounds__(512) k_hyena(Params p, int order) {
  extern __shared__ __attribute__((aligned(16))) char smem[];
  hyena_phase(p, smem);
}

#define VSTR 144
#define ATT_WAVE_LDS (32 * VSTR)
#define ATT_OL_OFF (8 * ATT_WAVE_LDS)
#define OLSTR 136
#define ATT_ML_OFF (ATT_OL_OFF + 512 * OLSTR)
typedef short v4s __attribute__((ext_vector_type(4)));
typedef __attribute__((address_space(3))) v4s* lds_v4s_ptr;

struct AttnLane { int n, h, troff, vkey0, vpart; };

template <int QS>
__device__ __forceinline__ void attn_tiles(const u16* __restrict__ Kb, const u16* __restrict__ Vb, int seqbase, int L, int tmin, int tq,
                                           const AttnLane& al, char* vl, int dil, int ntile, float nslope,
                                           bf16x8 qf0, bf16x8 qf1, bf16x8 qf2, bf16x8 qf3,
                                           f32x16& o0, f32x16& o1, float& m_run, float& l_run) {
  const int n = al.n, h = al.h;
  const int kbase = tmin - 64 * dil;
  const float fd = (float)dil;
  const float dl0 = (float)(-64 * dil - QS * n + 4 * h * dil);
  const float lo = fmaxf(-64.f * fd, -(float)tq);
  const float hi = fminf(64.f * fd, (float)(L - 1 - tq));
  const float vmid = 0.5f * (lo + hi), vhalf = 0.5f * (hi - lo);
  int ja = 0, jb = ntile - 1;
  while (ja <= jb && (kbase + 32 * ja * dil + 31 * dil < 0)) ++ja;
  while (jb >= ja && (kbase + 32 * jb * dil >= L)) --jb;
  if (ja > jb) return;
#define ATT_LOADKV(SFX, J) do { \
    const int tk0_ = kbase + 32 * (J) * dil; \
    int tk_ = tk0_ + n * dil; tk_ = min(max(tk_, 0), L - 1); \
    const u16* krow_ = Kb + (long)(seqbase + tk_) * 512 + 8 * h; \
    k0##SFX = *(const bf16x8*)(krow_); k1##SFX = *(const bf16x8*)(krow_ + 16); k2##SFX = *(const bf16x8*)(krow_ + 32); k3##SFX = *(const bf16x8*)(krow_ + 48); \
    int tv_; \
    tv_ = tk0_ + (al.vkey0) * dil; tv_ = min(max(tv_, 0), L - 1); v0##SFX = *(const uint4*)(Vb + (long)(seqbase + tv_) * 512 + al.vpart * 8); \
    tv_ = tk0_ + (al.vkey0 + 8) * dil; tv_ = min(max(tv_, 0), L - 1); v1##SFX = *(const uint4*)(Vb + (long)(seqbase + tv_) * 512 + al.vpart * 8); \
    tv_ = tk0_ + (al.vkey0 + 16) * dil; tv_ = min(max(tv_, 0), L - 1); v2##SFX = *(const uint4*)(Vb + (long)(seqbase + tv_) * 512 + al.vpart * 8); \
    tv_ = tk0_ + (al.vkey0 + 24) * dil; tv_ = min(max(tv_, 0), L - 1); v3##SFX = *(const uint4*)(Vb + (long)(seqbase + tv_) * 512 + al.vpart * 8); } while (0)
#define ATT_STAGEV(SFX) do { \
    *(uint4*)(vl + (al.vkey0) * VSTR + al.vpart * 16) = v0##SFX; \
    *(uint4*)(vl + (al.vkey0 + 8) * VSTR + al.vpart * 16) = v1##SFX; \
    *(uint4*)(vl + (al.vkey0 + 16) * VSTR + al.vpart * 16) = v2##SFX; \
    *(uint4*)(vl + (al.vkey0 + 24) * VSTR + al.vpart * 16) = v3##SFX; } while (0)
  bf16x8 k0A, k1A, k2A, k3A, k0B, k1B, k2B, k3B;
  uint4 v0A, v1A, v2A, v3A, v0B, v1B, v2B, v3B;
  auto tile = [&](int j, bf16x8 kf0, bf16x8 kf1, bf16x8 kf2, bf16x8 kf3) {
    f32x16 S;
#pragma unroll
    for (int jj = 0; jj < 16; ++jj) S[jj] = 0.f;
    S = __builtin_amdgcn_mfma_f32_32x32x16_bf16(kf0, qf0, S, 0, 0, 0);
    S = __builtin_amdgcn_mfma_f32_32x32x16_bf16(kf1, qf1, S, 0, 0, 0);
    S = __builtin_amdgcn_mfma_f32_32x32x16_bf16(kf2, qf2, S, 0, 0, 0);
    S = __builtin_amdgcn_mfma_f32_32x32x16_bf16(kf3, qf3, S, 0, 0, 0);
    const float dt = dl0 + (float)(32 * j * dil);
    float mx = -1e30f;
#pragma unroll
    for (int jj = 0; jj < 16; ++jj) {
      float delta = dt + fd * (float)((jj & 3) + 8 * (jj >> 2));
      bool ok = fabsf(delta - vmid) <= vhalf;
      float sc = S[jj] + nslope * fabsf(delta);
      sc = ok ? sc : -1e30f;
      S[jj] = sc;
      mx = fmaxf(mx, sc);
    }
    mx = fmaxf(mx, __shfl_xor(mx, 32));
    const float m_new = fmaxf(m_run, mx);
    const float alpha = __builtin_amdgcn_exp2f(m_run - m_new);
    m_run = m_new;
    const float m_safe = fmaxf(m_new, -1e20f);
    float psum = 0.f;
    float pv[16];
#pragma unroll
    for (int jj = 0; jj < 16; ++jj) {
      float pe = __builtin_amdgcn_exp2f(S[jj] - m_safe);
      pv[jj] = pe; psum += pe;
    }
    l_run = l_run * alpha + psum;
#pragma unroll
    for (int jj = 0; jj < 16; ++jj) { o0[jj] *= alpha; o1[jj] *= alpha; }
    union { unsigned u[4]; bf16x8 v; } pf0, pf1;
#pragma unroll
    for (int q = 0; q < 4; ++q) { pf0.u[q] = pg8::cvt_pk_bf16(pv[2 * q], pv[2 * q + 1]); pf1.u[q] = pg8::cvt_pk_bf16(pv[8 + 2 * q], pv[8 + 2 * q + 1]); }
    __builtin_amdgcn_wave_barrier();
#define TRRD(s2, hh, dtt) __builtin_amdgcn_ds_read_tr16_b64_v4i16((lds_v4s_ptr)(vl + al.troff + (16 * (s2) + 8 * (hh)) * VSTR + 64 * (dtt)))
    {
      v4s a00 = TRRD(0, 0, 0), a01 = TRRD(0, 1, 0), b00 = TRRD(0, 0, 1), b01 = TRRD(0, 1, 1);
      v4s a10 = TRRD(1, 0, 0), a11 = TRRD(1, 1, 0), b10 = TRRD(1, 0, 1), b11 = TRRD(1, 1, 1);
      bf16x8 va0 = __builtin_shufflevector(a00, a01, 0, 1, 2, 3, 4, 5, 6, 7);
      bf16x8 vb0 = __builtin_shufflevector(b00, b01, 0, 1, 2, 3, 4, 5, 6, 7);
      bf16x8 va1 = __builtin_shufflevector(a10, a11, 0, 1, 2, 3, 4, 5, 6, 7);
      bf16x8 vb1 = __builtin_shufflevector(b10, b11, 0, 1, 2, 3, 4, 5, 6, 7);
      o0 = __builtin_amdgcn_mfma_f32_32x32x16_bf16(va0, pf0.v, o0, 0, 0, 0);
      o1 = __builtin_amdgcn_mfma_f32_32x32x16_bf16(vb0, pf0.v, o1, 0, 0, 0);
      o0 = __builtin_amdgcn_mfma_f32_32x32x16_bf16(va1, pf1.v, o0, 0, 0, 0);
      o1 = __builtin_amdgcn_mfma_f32_32x32x16_bf16(vb1, pf1.v, o1, 0, 0, 0);
    }
    __builtin_amdgcn_wave_barrier();
  };
  ATT_LOADKV(A, ja);
  if (ja + 1 <= jb) ATT_LOADKV(B, ja + 1);
#pragma unroll 1
  for (int j = ja; j <= jb; j += 2) {
    {
      const bf16x8 kf0 = k0A, kf1 = k1A, kf2 = k2A, kf3 = k3A;
      ATT_STAGEV(A);
      if (j + 2 <= jb) ATT_LOADKV(A, j + 2);
      tile(j, kf0, kf1, kf2, kf3);
    }
    if (j + 1 > jb) break;
    {
      const bf16x8 kf0 = k0B, kf1 = k1B, kf2 = k2B, kf3 = k3B;
      ATT_STAGEV(B);
      if (j + 3 <= jb) ATT_LOADKV(B, j + 3);
      tile(j + 1, kf0, kf1, kf2, kf3);
    }
  }
}

__device__ __forceinline__ void attn_unit(const Params& p, int unit, char* smem, int lane_in, int w, u16* obase) {
  int lane = lane_in; asm volatile("" : "+v"(lane));
  int seqbase, L, head, blk;
  if (unit < 512) { int sq = unit >> 6, rem = unit & 63; seqbase = sq * 4096; L = 4096; head = rem >> 3; blk = rem & 7; }
  else { int u2 = unit - 512; int sq = u2 >> 8, rem = u2 & 255; seqbase = 32768 + sq * 16384; L = 16384; head = rem >> 5; blk = rem & 31; }
  const int tb = blk * 512;
  AttnLane al;
  al.n = lane & 31; al.h = lane >> 5;
  { const int g = lane >> 4, i16 = lane & 15, tq4 = i16 >> 2, tp4 = i16 & 3;
    al.troff = (4 * (g >> 1) + tq4) * VSTR + (16 * (g & 1) + 4 * tp4) * 2; }
  al.vkey0 = lane >> 3; al.vpart = lane & 7;
  const int n = al.n, h = al.h;
  const u16* Qb = (const u16*)(p.ws + OFF_QB);
  const u16* Kb = (const u16*)(p.ws + OFF_KB) + head * 64;
  const u16* Vb = (const u16*)(p.ws + OFF_VB) + head * 64;
  char* vl = smem + w * ATT_WAVE_LDS;
  char* OL = smem + ATT_OL_OFF;
  float2* ML = (float2*)(smem + ATT_ML_OFF);
  const float nslope = -exp2f(-(float)(head + 1)) * LOG2E;
  bf16x8 qn0, qn1, qn2, qn3;
#define ATT_QLOAD(G) do { const int g_ = (G); if (g_ < 6) { \
    const int gg_ = 2 * w + (g_ & 1), ps_ = g_ >> 1; \
    const int tq_ = (ps_ == 0) ? (tb + 32 * gg_ + n) : ((ps_ == 1) ? (tb + (gg_ >> 2) * 128 + (gg_ & 3) + 4 * n) : (tb + gg_ + 16 * n)); \
    const u16* qr_ = Qb + (long)(seqbase + tq_) * 512 + head * 64; \
    qn0 = *(const bf16x8*)(qr_ + 8 * h); qn1 = *(const bf16x8*)(qr_ + 16 + 8 * h); \
    qn2 = *(const bf16x8*)(qr_ + 32 + 8 * h); qn3 = *(const bf16x8*)(qr_ + 48 + 8 * h); } } while (0)
  ATT_QLOAD(0);
  __syncthreads();
#pragma unroll 1
  for (int gi = 0; gi < 2; ++gi) {
    const int tl0 = 32 * (2 * w + gi);
    const int tmin = tb + tl0, tq = tmin + n;
    const bf16x8 qf0 = qn0, qf1 = qn1, qf2 = qn2, qf3 = qn3;
    ATT_QLOAD(0 + gi + 1);
    f32x16 o0, o1;
#pragma unroll
    for (int j = 0; j < 16; ++j) { o0[j] = 0.f; o1[j] = 0.f; }
    float m_run = -1e30f, l_run = 0.f;
    attn_tiles<1>(Kb, Vb, seqbase, L, tmin, tq, al, vl, 1, 5, nslope, qf0, qf1, qf2, qf3, o0, o1, m_run, l_run);
    const float ltot = l_run + __shfl_xor(l_run, 32);
    const float inv = 1.f / ltot;
    char* orow = OL + (tl0 + n) * OLSTR;
#pragma unroll
    for (int g4 = 0; g4 < 4; ++g4) {
      uint2 w0, w1;
      w0.x = pack2(o0[4 * g4] * inv, o0[4 * g4 + 1] * inv); w0.y = pack2(o0[4 * g4 + 2] * inv, o0[4 * g4 + 3] * inv);
      w1.x = pack2(o1[4 * g4] * inv, o1[4 * g4 + 1] * inv); w1.y = pack2(o1[4 * g4 + 2] * inv, o1[4 * g4 + 3] * inv);
      *(uint2*)(orow + (8 * g4 + 4 * h) * 2) = w0;
      *(uint2*)(orow + (32 + 8 * g4 + 4 * h) * 2) = w1;
    }
    if (h == 0) ML[tl0 + n] = make_float2(m_run, ltot);
  }
  __syncthreads();
#pragma unroll 1
  for (int gi = 0; gi < 2; ++gi) {
    const int g = 2 * w + gi;
    const int tl0 = (g >> 2) * 128 + (g & 3);
    const int tmin = tb + tl0, tq = tmin + 4 * n;
    const int tl = tl0 + 4 * n;
    const bf16x8 qf0 = qn0, qf1 = qn1, qf2 = qn2, qf3 = qn3;
    ATT_QLOAD(2 + gi + 1);
    const float2 ml = ML[tl];
    float m_run = ml.x, l_run = (h == 0) ? ml.y : 0.f;
    f32x16 o0, o1;
    char* orow = OL + tl * OLSTR;
#pragma unroll
    for (int g4 = 0; g4 < 4; ++g4) {
      uint2 w0 = *(const uint2*)(orow + (8 * g4 + 4 * h) * 2), w1 = *(const uint2*)(orow + (32 + 8 * g4 + 4 * h) * 2);
      o0[4 * g4] = bflo(w0.x) * ml.y; o0[4 * g4 + 1] = bfhi(w0.x) * ml.y; o0[4 * g4 + 2] = bflo(w0.y) * ml.y; o0[4 * g4 + 3] = bfhi(w0.y) * ml.y;
      o1[4 * g4] = bflo(w1.x) * ml.y; o1[4 * g4 + 1] = bfhi(w1.x) * ml.y; o1[4 * g4 + 2] = bflo(w1.y) * ml.y; o1[4 * g4 + 3] = bfhi(w1.y) * ml.y;
    }
    attn_tiles<4>(Kb, Vb, seqbase, L, tmin, tq, al, vl, 4, 5, nslope, qf0, qf1, qf2, qf3, o0, o1, m_run, l_run);
    const float ltot = l_run + __shfl_xor(l_run, 32);
    const float inv = 1.f / ltot;
#pragma unroll
    for (int g4 = 0; g4 < 4; ++g4) {
      uint2 w0, w1;
      w0.x = pack2(o0[4 * g4] * inv, o0[4 * g4 + 1] * inv); w0.y = pack2(o0[4 * g4 + 2] * inv, o0[4 * g4 + 3] * inv);
      w1.x = pack2(o1[4 * g4] * inv, o1[4 * g4 + 1] * inv); w1.y = pack2(o1[4 * g4 + 2] * inv, o1[4 * g4 + 3] * inv);
      *(uint2*)(orow + (8 * g4 + 4 * h) * 2) = w0;
      *(uint2*)(orow + (32 + 8 * g4 + 4 * h) * 2) = w1;
    }
    if (h == 0) ML[tl] = make_float2(m_run, ltot);
  }
  __syncthreads();
#pragma unroll 1
  for (int ri = 0; ri < 2; ++ri) {
    const int r = 2 * w + ri;
    const int tmin = tb + r, tq = tmin + 16 * n;
    const int tl = r + 16 * n;
    const bf16x8 qf0 = qn0, qf1 = qn1, qf2 = qn2, qf3 = qn3;
    ATT_QLOAD(4 + ri + 1);
    const float2 ml = ML[tl];
    float m_run = ml.x, l_run = (h == 0) ? ml.y : 0.f;
    f32x16 o0, o1;
    const char* orow = OL + tl * OLSTR;
#pragma unroll
    for (int g4 = 0; g4 < 4; ++g4) {
      uint2 w0 = *(const uint2*)(orow + (8 * g4 + 4 * h) * 2), w1 = *(const uint2*)(orow + (32 + 8 * g4 + 4 * h) * 2);
      o0[4 * g4] = bflo(w0.x) * ml.y; o0[4 * g4 + 1] = bfhi(w0.x) * ml.y; o0[4 * g4 + 2] = bflo(w0.y) * ml.y; o0[4 * g4 + 3] = bfhi(w0.y) * ml.y;
      o1[4 * g4] = bflo(w1.x) * ml.y; o1[4 * g4 + 1] = bfhi(w1.x) * ml.y; o1[4 * g4 + 2] = bflo(w1.y) * ml.y; o1[4 * g4 + 3] = bfhi(w1.y) * ml.y;
    }
    attn_tiles<16>(Kb, Vb, seqbase, L, tmin, tq, al, vl, 16, 5, nslope, qf0, qf1, qf2, qf3, o0, o1, m_run, l_run);
    const float ltot = l_run + __shfl_xor(l_run, 32);
    const float inv = 1.f / ltot;
    u16* orow_g = obase + (long)(seqbase + tq) * 512 + head * 64;
#pragma unroll
    for (int g4 = 0; g4 < 4; ++g4) {
      uint2 w0, w1;
      w0.x = pack2(o0[4 * g4] * inv, o0[4 * g4 + 1] * inv); w0.y = pack2(o0[4 * g4 + 2] * inv, o0[4 * g4 + 3] * inv);
      w1.x = pack2(o1[4 * g4] * inv, o1[4 * g4 + 1] * inv); w1.y = pack2(o1[4 * g4 + 2] * inv, o1[4 * g4 + 3] * inv);
      *(uint2*)(orow_g + 8 * g4 + 4 * h) = w0;
      *(uint2*)(orow_g + 32 + 8 * g4 + 4 * h) = w1;
    }
  }
}

__device__ __forceinline__ void attn_phase(const Params& p, char* smem, u16* obase) {
  const int lane = threadIdx.x & 63;
  const int w = __builtin_amdgcn_readfirstlane(threadIdx.x >> 6);
  if (gridDim.x == 256) {
    const int x = blockIdx.x & 7, c = blockIdx.x >> 3;
#pragma unroll 1
    for (int k = 0; k < 4; ++k) attn_unit(p, x * 128 + k * 32 + c, smem, lane, w, obase);
  } else {
    const int per = (1024 + gridDim.x - 1) / gridDim.x;
#pragma unroll 1
    for (int k = 0; k < per; ++k) {
      int unit = blockIdx.x * per + k;
      if (unit < 1024) attn_unit(p, unit, smem, lane, w, obase);
    }
  }
}
#define ATTN_PHASE(p, smem) attn_phase(p, smem, (u16*)(p.ws + OFF_QB))

#define MEGA_LDS HY_LDS
#ifndef PROBE_DOUBLE
#define PROBE_DOUBLE 0
#endif
#ifndef ATTN_PHASE
#define ATTN_PHASE(p, smem) attn_naive_phase(p)
#endif

__global__ void __launch_bounds__(512) mega(Params p) {
  extern __shared__ __attribute__((aligned(16))) char smem[];
  cg::grid_group grid = cg::this_grid();
  phase0(p, smem);
  convert_wout(p);
  grid.sync();
  phase1_v8(p, smem);
  grid.sync();
  ATTN_PHASE(p, smem);
  hyena_phase(p, smem);
  grid.sync();
  phase4_v8(p, smem);
}

static Params make_params(void* const* d_in, void* d_out, void* d_ws) {
  Params p{};
  p.x0 = (const float*)d_in[0]; p.x1 = (const float*)d_in[1]; p.w_in = (const float*)d_in[2];
  p.conv_w = (const float*)d_in[3]; p.conv_b = (const float*)d_in[4];
  p.fw1 = (const float*)d_in[5]; p.fb1 = (const float*)d_in[6]; p.fw2 = (const float*)d_in[7]; p.fb2 = (const float*)d_in[8];
  p.fw3 = (const float*)d_in[9]; p.fb3 = (const float*)d_in[10]; p.ffreq = (const float*)d_in[11]; p.fw4 = (const float*)d_in[12];
  p.hyd = (const float*)d_in[13]; p.gna = (const float*)d_in[14]; p.gnh = (const float*)d_in[15];
  p.w_out = (const float*)d_in[16]; p.lng = (const float*)d_in[17]; p.lnb = (const float*)d_in[18];
  p.out = (float*)d_out; p.ws = (char*)d_ws;
  return p;
}

extern "C" void kernel_launch(void* const* d_in, const int* in_sizes, int n_in,
                              void* d_out, int out_size, void* d_ws, size_t ws_size,
                              hipStream_t stream) {
  Params p = make_params(d_in, d_out, d_ws);
  static int grid_blocks = 0;
  if (!grid_blocks) {
    (void)hipFuncSetAttribute((const void*)mega, hipFuncAttributeMaxDynamicSharedMemorySize, MEGA_LDS);
    int dev = 0, cus = 0, per_cu = 0;
    (void)hipGetDevice(&dev);
    (void)hipDeviceGetAttribute(&cus, hipDeviceAttributeMultiprocessorCount, dev);
    (void)hipOccupancyMaxActiveBlocksPerMultiprocessor(&per_cu, mega, 512, MEGA_LDS);
    if (per_cu < 1) per_cu = 1;
    grid_blocks = cus;
    if (grid_blocks > 256) grid_blocks = 256;
  }
  void* args[] = {&p};
  hipError_t e = hipLaunchCooperativeKernel((void*)mega, dim3(grid_blocks), dim3(512), args, MEGA_LDS, stream);
  if (e != hipSuccess) fprintf(stderr, "cooperative launch failed: %s (grid %d)\n", hipGetErrorString(e), grid_blocks);
}
```

```cpp
#include <hip/hip_runtime.h>
#include <hip/hip_cooperative_groups.h>
#include <cstdio>
namespace cg = cooperative_groups;

typedef unsigned short u16;
typedef short bf16x8 __attribute__((ext_vector_type(8)));
typedef short s16x4 __attribute__((ext_vector_type(4)));
typedef float f32x16 __attribute__((ext_vector_type(16)));
typedef float f32x2 __attribute__((ext_vector_type(2)));

#define NTOK 65536
#define MiB (1024L * 1024L)
#define OFF_QB (0 * MiB)
#define OFF_KB (64 * MiB)
#define OFF_VB (128 * MiB)
#define OFF_GB (192 * MiB)
#define OFF_UT (320 * MiB)
#define OFF_MIXED (64 * MiB)
#define OFF_WBOUT (384 * MiB)
#define OFF_Z2T (320 * MiB)
#define OFF_XB (0 * MiB)
#define OFF_Z1T (0 * MiB)
#define OFF_Z0T (64 * MiB)
#define LG_S 32832
#define LG_P 8256
#define OFF_GRS (128 * MiB)
#define OFF_GRP (128 * MiB + 1024L * LG_S * 2)
#define OFF_WBIN (212 * MiB)

__device__ unsigned short g_wbout[1024 * 1024];

struct Params {
  const float *x0, *x1, *w_in, *conv_w, *conv_b, *fw1, *fb1, *fw2, *fb2, *fw3, *fb3, *ffreq, *fw4, *hyd, *gna, *gnh, *w_out, *lng, *lnb;
  float* out;
  char* ws;
};

__device__ __forceinline__ u16 f2bf(float f) {
  unsigned u = __float_as_uint(f);
  u += 0x7fffu + ((u >> 16) & 1u);
  return (u16)(u >> 16);
}
__device__ __forceinline__ float bf2f(u16 b) { return __uint_as_float(((unsigned)b) << 16); }
__device__ __forceinline__ unsigned pack2(float a, float b) { return (unsigned)f2bf(a) | ((unsigned)f2bf(b) << 16); }
__device__ __forceinline__ float bflo(unsigned u) { return __uint_as_float(u << 16); }
__device__ __forceinline__ float bfhi(unsigned u) { return __uint_as_float(u & 0xffff0000u); }
__device__ __forceinline__ float silu_f(float x) { return x / (1.f + __expf(-x)); }

__device__ __forceinline__ void tok_info(int tok, int& t, int& L, int& seqbase) {
  if (tok < 32768) { L = 4096; t = tok & 4095; seqbase = tok & ~4095; }
  else { L = 16384; t = tok & 16383; seqbase = tok & ~16383; }
}

__device__ __forceinline__ void filter_item(const Params& p, int item, char* smem) {
  const int tid = threadIdx.x;
  const bool samp = item < 1024;
  const int L = samp ? 16384 : 4096;
  const int LG = samp ? LG_S : LG_P;
  const int it2 = samp ? item : item - 1024;
  const int q = it2 & 3;
  const int l0 = (it2 >> 2) * 64;
  const int n = q >> 1, dir = q & 1;
  const int lagbase = l0 + (dir == 0 ? 1 : 0);
  u16* GR = (u16*)((char*)p.out + (samp ? OFF_GRS : OFF_GRP));
  float* zs = (float*)smem;
  float* ha = zs + 64 * 36;
  float* hb = ha + 64 * 64;
  __syncthreads();
  for (int i = tid; i < 64 * 33; i += 512) {
    int l = i / 33, f = i - l * 33;
    int lag = lagbase + l;
    float t = (float)lag / (float)(L - 1);
    float w = (float)lag / (float)L;
    float v;
    if (f == 0) v = t;
    else {
      int j = (f - 1) & 15;
      float fr = 1e-4f + (float)j * ((15.0f - 1e-4f) / 15.0f);
      float a = fr * w;
      v = (f <= 16) ? __builtin_amdgcn_cosf(a) : -__builtin_amdgcn_sinf(a);
    }
    zs[l * 36 + f] = v;
  }
  __syncthreads();
  {
    const int u = tid & 63, lb = tid >> 6;
    float acc[8];
    const float bb = p.fb1[u];
#pragma unroll
    for (int qq = 0; qq < 8; ++qq) acc[qq] = bb;
    float wa[8], wn[8];
#pragma unroll
    for (int i = 0; i < 8; ++i) wa[i] = p.fw1[i * 64 + u];
#pragma unroll 1
    for (int fb = 0; fb < 4; ++fb) {
      const int fn = (fb + 1 < 4) ? (fb + 1) * 8 : 0;
#pragma unroll
      for (int i = 0; i < 8; ++i) wn[i] = p.fw1[(fn + i) * 64 + u];
#pragma unroll
      for (int i = 0; i < 8; ++i) {
        const int f = fb * 8 + i;
#pragma unroll
        for (int qq = 0; qq < 8; ++qq) acc[qq] += zs[(lb + 8 * qq) * 36 + f] * wa[i];
      }
#pragma unroll
      for (int i = 0; i < 8; ++i) wa[i] = wn[i];
    }
    { const float wv = p.fw1[32 * 64 + u];
#pragma unroll
      for (int qq = 0; qq < 8; ++qq) acc[qq] += zs[(lb + 8 * qq) * 36 + 32] * wv; }
    const float fq = p.ffreq[0 + u];
#pragma unroll
    for (int qq = 0; qq < 8; ++qq) { const int l = lb + 8 * qq; ha[l * 64 + u] = __sinf(fq * acc[qq]); }
  }
  __syncthreads();
  {
    const int u = tid & 63, lb = tid >> 6;
    float acc[8];
    const float bb = p.fb2[u];
#pragma unroll
    for (int qq = 0; qq < 8; ++qq) acc[qq] = bb;
    float wa[8], wn[8];
#pragma unroll
    for (int i = 0; i < 8; ++i) wa[i] = p.fw2[i * 64 + u];
#pragma unroll 1
    for (int fb = 0; fb < 8; ++fb) {
      const int fn = (fb + 1 < 8) ? (fb + 1) * 8 : 0;
#pragma unroll
      for (int i = 0; i < 8; ++i) wn[i] = p.fw2[(fn + i) * 64 + u];
#pragma unroll
      for (int i = 0; i < 8; ++i) {
        const int f = fb * 8 + i;
#pragma unroll
        for (int qq = 0; qq < 8; ++qq) acc[qq] += ha[(lb + 8 * qq) * 64 + f] * wa[i];
      }
#pragma unroll
      for (int i = 0; i < 8; ++i) wa[i] = wn[i];
    }
    const float fq = p.ffreq[64 + u];
#pragma unroll
    for (int qq = 0; qq < 8; ++qq) { const int l = lb + 8 * qq; hb[l * 64 + u] = __sinf(fq * acc[qq]); }
  }
  __syncthreads();
  {
    const int u = tid & 63, lb = tid >> 6;
    float acc[8];
    const float bb = p.fb3[u];
#pragma unroll
    for (int qq = 0; qq < 8; ++qq) acc[qq] = bb;
    float wa[8], wn[8];
#pragma unroll
    for (int i = 0; i < 8; ++i) wa[i] = p.fw3[i * 64 + u];
#pragma unroll 1
    for (int fb = 0; fb < 8; ++fb) {
      const int fn = (fb + 1 < 8) ? (fb + 1) * 8 : 0;
#pragma unroll
      for (int i = 0; i < 8; ++i) wn[i] = p.fw3[(fn + i) * 64 + u];
#pragma unroll
      for (int i = 0; i < 8; ++i) {
        const int f = fb * 8 + i;
#pragma unroll
        for (int qq = 0; qq < 8; ++qq) acc[qq] += hb[(lb + 8 * qq) * 64 + f] * wa[i];
      }
#pragma unroll
      for (int i = 0; i < 8; ++i) wa[i] = wn[i];
    }
    const float fq = p.ffreq[128 + u];
#pragma unroll
    for (int qq = 0; qq < 8; ++qq) { const int l = lb + 8 * qq; ha[u * 64 + l] = __sinf(fq * acc[qq]); }
  }
  __syncthreads();
  const int c = tid;
  const float min_decay = -3.0701134573253943f;
  const float max_decay = -15.350567286626972f;
  const float delta = fabsf(min_decay + (max_decay - min_decay) * ((float)c / 511.0f));
  f32x2 acc2[32];
#pragma unroll
  for (int l = 0; l < 32; ++l) acc2[l] = (f32x2){0.f, 0.f};
  float a0 = 0.f;
  const bool need0 = (dir == 1) && (l0 == 0);
  float wnext = p.fw4[q * 512 + c];
#pragma unroll 1
  for (int j = 0; j < 64; ++j) {
    const float wv = wnext;
    wnext = p.fw4[((j + 1) & 63) * 2048 + q * 512 + c];
    const float4* hr = (const float4*)(ha + j * 64);
    const f32x2 wv2 = {wv, wv};
#pragma unroll
    for (int l4 = 0; l4 < 16; ++l4) {
      float4 hv = hr[l4];
      f32x2 h01 = {hv.x, hv.y}, h23 = {hv.z, hv.w};
      acc2[2 * l4] = __builtin_elementwise_fma(h01, wv2, acc2[2 * l4]);
      acc2[2 * l4 + 1] = __builtin_elementwise_fma(h23, wv2, acc2[2 * l4 + 1]);
    }
    if (need0) a0 += ha[j * 64] * p.fw4[j * 2048 + (q - 1) * 512 + c];
  }
  float acc[64];
#pragma unroll
  for (int l = 0; l < 32; ++l) { acc[2 * l] = acc2[l][0]; acc[2 * l + 1] = acc2[l][1]; }
  if (need0) acc[0] = a0;
  const float tinv = 1.f / (float)(L - 1);
#pragma unroll
  for (int l = 0; l < 64; ++l) {
    int lag = lagbase + l;
    float v = acc[l] * expf(-(float)lag * tinv * delta);
    acc[l] = (lag >= L) ? 0.f : v;
  }
  u16* row = GR + (long)(n * 512 + c) * LG;
  if (dir == 1) {
    u16* dst = row + (L + 32 + l0);
#pragma unroll
    for (int e = 0; e < 8; ++e) {
      uint4 o;
      o.x = pack2(acc[8 * e + 0], acc[8 * e + 1]); o.y = pack2(acc[8 * e + 2], acc[8 * e + 3]);
      o.z = pack2(acc[8 * e + 4], acc[8 * e + 5]); o.w = pack2(acc[8 * e + 6], acc[8 * e + 7]);
      *(uint4*)(dst + 8 * e) = o;
    }
  } else {
    u16* dst = row + (L + 32 - l0 - 64);
#pragma unroll
    for (int e = 0; e < 8; ++e) {
      uint4 o;
      o.x = pack2(acc[63 - 8 * e], acc[62 - 8 * e]); o.y = pack2(acc[61 - 8 * e], acc[60 - 8 * e]);
      o.z = pack2(acc[59 - 8 * e], acc[58 - 8 * e]); o.w = pack2(acc[57 - 8 * e], acc[56 - 8 * e]);
      *(uint4*)(dst + 8 * e) = o;
    }
    if (l0 == 0) {
      const uint4 z4 = make_uint4(0, 0, 0, 0);
#pragma unroll
      for (int e = 0; e < 4; ++e) { *(uint4*)(row + 8 * e) = z4; *(uint4*)(row + 2 * L + 32 + 8 * e) = z4; }
    }
  }
}

__device__ __forceinline__ void phase0_convert(const Params& p) {
  const int tid = threadIdx.x, bid = blockIdx.x, nb = gridDim.x;
  u16* xb = (u16*)((char*)p.out + OFF_XB);
  const long nchunk = (long)NTOK * 1024 / 8;
  for (long c0 = (long)bid * 512 + tid; c0 < nchunk; c0 += (long)nb * 512 * 4) {
    float4 a[4], b[4];
#pragma unroll
    for (int q = 0; q < 4; ++q) {
      long e = (c0 + (long)q * nb * 512) * 8;
      const float* src = (e < 32768L * 1024) ? (p.x0 + e) : (p.x1 + (e - 32768L * 1024));
      a[q] = *(const float4*)src; b[q] = *(const float4*)(src + 4);
    }
#pragma unroll
    for (int q = 0; q < 4; ++q) {
      long e = (c0 + (long)q * nb * 512) * 8;
      uint4 o;
      o.x = pack2(a[q].x, a[q].y); o.y = pack2(a[q].z, a[q].w); o.z = pack2(b[q].x, b[q].y); o.w = pack2(b[q].z, b[q].w);
      *(uint4*)(xb + e) = o;
    }
  }
  u16* wbin = (u16*)((char*)p.out + OFF_WBIN);
  for (int id = bid * 512 + tid; id < 4096 * 128; id += nb * 512) {
    int n = id & 4095, kc = id >> 12;
    float v[8];
#pragma unroll
    for (int j = 0; j < 8; ++j) v[j] = p.w_in[(long)(kc * 8 + j) * 4096 + n];
    uint4 o;
    o.x = pack2(v[0], v[1]); o.y = pack2(v[2], v[3]); o.z = pack2(v[4], v[5]); o.w = pack2(v[6], v[7]);
    *(uint4*)(wbin + (long)n * 1024 + kc * 8) = o;
  }
}

__device__ __forceinline__ void phase0(const Params& p, char* smem) {
  const int bid = blockIdx.x, nb = gridDim.x;
  if (bid & 1) {
    for (int item = bid; item < 1280; item += nb) filter_item(p, item, smem);
    phase0_convert(p);
  } else {
    phase0_convert(p);
    for (int item = bid; item < 1280; item += nb) filter_item(p, item, smem);
  }
}

__device__ __forceinline__ void convert_wout(const Params& p) {
  const int tid = threadIdx.x, bid = blockIdx.x, nb = gridDim.x;
  u16* wb = g_wbout;
  for (int id = bid * 512 + tid; id < 1024 * 128; id += nb * 512) {
    int n = id & 1023, kc = id >> 10;
    float v[8];
#pragma unroll
    for (int j = 0; j < 8; ++j) v[j] = p.w_out[(long)(kc * 8 + j) * 1024 + n];
    uint4 o;
    o.x = pack2(v[0], v[1]); o.y = pack2(v[2], v[3]); o.z = pack2(v[4], v[5]); o.w = pack2(v[6], v[7]);
    *(uint4*)(wb + (long)n * 1024 + kc * 8) = o;
  }
}

#define QSCALE 0.18033688011112042f
#define LOG2E 1.4426950408889634f

__device__ __forceinline__ void inproj_store1(const Params& p, int tok, int col, float v) {
  u16* ws16 = (u16*)p.ws;
  if (col < 512) ws16[(OFF_QB >> 1) + (long)tok * 512 + col] = f2bf(v * QSCALE);
  else if (col < 1024) ws16[(OFF_KB >> 1) + (long)tok * 512 + (col - 512)] = f2bf(v);
  else if (col < 1536) ws16[(OFF_VB >> 1) + (long)tok * 512 + (col - 1024)] = f2bf(v);
  else if (col < 2048) ws16[(OFF_GB >> 1) + (long)tok * 1024 + (col - 1536)] = f2bf(silu_f(v));
  else if (col < 3584) ws16[(OFF_UT >> 1) + (long)(col - 2048) * NTOK + tok] = f2bf(v);
  else ws16[(OFF_GB >> 1) + (long)tok * 1024 + 512 + (col - 3584)] = f2bf(silu_f(v));
}

__device__ __forceinline__ float shortconv_at(const Params& p, int ch, int tok) {
  const u16* row = (const u16*)(p.ws + OFF_UT) + (long)ch * NTOK;
  int t, L, sb; tok_info(tok, t, L, sb);
  float a = (t > 0) ? bf2f(row[tok - 1]) : 0.f;
  float b = bf2f(row[tok]);
  float c = (t < L - 1) ? bf2f(row[tok + 1]) : 0.f;
  return p.conv_b[ch] + p.conv_w[ch] * a + p.conv_w[1536 + ch] * b + p.conv_w[3072 + ch] * c;
}

__global__ void __launch_bounds__(512) k_phase0(Params p) {
  extern __shared__ __attribute__((aligned(16))) char smem[];
  phase0(p, smem);
}
__global__ void __launch_bounds__(512) k_convert_wout(Params p) { convert_wout(p); }

__global__ void __launch_bounds__(256) n_inproj(Params p) {
  long gid = (long)blockIdx.x * 256 + threadIdx.x;
  int col = (int)(gid & 4095), tok = (int)(gid >> 12);
  const u16* xb = (const u16*)((char*)p.out + OFF_XB) + (long)tok * 1024;
  const u16* wb = (const u16*)((char*)p.out + OFF_WBIN) + (long)col * 1024;
  float acc = 0.f;
  for (int k = 0; k < 1024; k += 8) {
    uint4 a = *(const uint4*)(xb + k), b = *(const uint4*)(wb + k);
    acc += bflo(a.x) * bflo(b.x) + bfhi(a.x) * bfhi(b.x) + bflo(a.y) * bflo(b.y) + bfhi(a.y) * bfhi(b.y)
         + bflo(a.z) * bflo(b.z) + bfhi(a.z) * bfhi(b.z) + bflo(a.w) * bflo(b.w) + bfhi(a.w) * bfhi(b.w);
  }
  inproj_store1(p, tok, col, acc);
}

__global__ void __launch_bounds__(256) n_attn(Params p) {
  int gid = blockIdx.x * 256 + threadIdx.x;
  int tok = gid & 65535, head = gid >> 16;
  int t, L, sb; tok_info(tok, t, L, sb);
  u16* Qb = (u16*)(p.ws + OFF_QB);
  const u16* Kb = (const u16*)(p.ws + OFF_KB);
  const u16* Vb = (const u16*)(p.ws + OFF_VB);
  float q[64], o[64];
#pragma unroll
  for (int d = 0; d < 64; ++d) { q[d] = bf2f(Qb[(long)tok * 512 + head * 64 + d]); o[d] = 0.f; }
  float m = -1e30f, l = 0.f;
  const float slope2 = exp2f(-(float)(head + 1)) * LOG2E;
  for (int pat = 0; pat < 3; ++pat) {
    int dil = (pat == 0) ? 1 : (pat == 1 ? 4 : 16);
    for (int j = -64; j <= 64; ++j) {
      int tk = t + j * dil;
      if (tk < 0 || tk >= L) continue;
      const u16* kr = Kb + (long)(sb + tk) * 512 + head * 64;
      const u16* vr = Vb + (long)(sb + tk) * 512 + head * 64;
      float s = 0.f;
#pragma unroll
      for (int d = 0; d < 64; ++d) s += q[d] * bf2f(kr[d]);
      s -= slope2 * (float)(abs(j) * dil);
      if (s > m) {
        float sc = exp2f(m - s);
        l *= sc;
#pragma unroll
        for (int d = 0; d < 64; ++d) o[d] *= sc;
        m = s;
      }
      float pr = exp2f(s - m);
      l += pr;
#pragma unroll
      for (int d = 0; d < 64; ++d) o[d] += pr * bf2f(vr[d]);
    }
  }
  float inv = 1.f / l;
#pragma unroll
  for (int d = 0; d < 64; ++d) Qb[(long)tok * 512 + head * 64 + d] = f2bf(o[d] * inv);
}

__global__ void __launch_bounds__(256) n_z0(Params p) {
  int gid = blockIdx.x * 256 + threadIdx.x;
  int tok = gid & 65535, c = gid >> 16;
  u16* z0 = (u16*)((char*)p.out + OFF_Z0T);
  z0[(long)c * NTOK + tok] = f2bf(shortconv_at(p, c, tok));
}

__global__ void __launch_bounds__(256) n_conv(Params p, int order) {
  int gid = blockIdx.x * 256 + threadIdx.x;
  int tok = gid & 65535, c = gid >> 16;
  int t, L, sb; tok_info(tok, t, L, sb);
  const bool samp = tok >= 32768;
  const u16* src = (order == 0) ? (const u16*)((char*)p.out + OFF_Z0T) : (const u16*)((char*)p.out + OFF_Z1T);
  const u16* urow = src + (long)c * NTOK + sb;
  const u16* gr = (const u16*)((char*)p.out + (samp ? OFF_GRS : OFF_GRP)) + (long)(order * 512 + c) * (samp ? LG_S : LG_P);
  const u16* g0 = gr + (L + 32 - t);
  float y = 0.f;
  for (int s = 0; s < L; ++s) y += bf2f(g0[s]) * bf2f(urow[s]);
  float gate = shortconv_at(p, 512 * (order + 1) + c, tok);
  float dv = p.hyd[order * 512 + c];
  float r = gate * (y + dv * bf2f(urow[t]));
  u16* dst = (order == 0) ? (u16*)((char*)p.out + OFF_Z1T) : (u16*)(p.ws + OFF_Z2T);
  dst[(long)c * NTOK + tok] = f2bf(r);
}

__global__ void __launch_bounds__(256) n_outproj(Params p) {
  long gid = (long)blockIdx.x * 256 + threadIdx.x;
  int col = (int)(gid & 1023), tok = (int)(gid >> 10);
  const u16* a = (const u16*)(p.ws + OFF_MIXED) + (long)tok * 1024;
  const u16* wb = (const u16*)(p.ws + OFF_WBOUT) + (long)col * 1024;
  float acc = 0.f;
  for (int k = 0; k < 1024; k += 8) {
    uint4 x = *(const uint4*)(a + k), b = *(const uint4*)(wb + k);
    acc += bflo(x.x) * bflo(b.x) + bfhi(x.x) * bfhi(b.x) + bflo(x.y) * bflo(b.y) + bfhi(x.y) * bfhi(b.y)
         + bflo(x.z) * bflo(b.z) + bfhi(x.z) * bfhi(b.z) + bflo(x.w) * bflo(b.w) + bfhi(x.w) * bfhi(b.w);
  }
  const float* xr = (tok < 32768) ? (p.x0 + (long)tok * 1024) : (p.x1 + (long)(tok - 32768) * 1024);
  p.out[(long)tok * 1024 + col] = 1.189207115002721f * xr[col] + acc;
}

__device__ __forceinline__ float wave_sum(float v) {
#pragma unroll
  for (int o = 32; o; o >>= 1) v += __shfl_xor(v, o);
  return v;
}

__device__ __forceinline__ void mixed_row(const Params& p, int tok, int lane) {
  u16* mixed = (u16*)(p.ws + OFF_MIXED) + (long)tok * 1024;
  const u16* Gb = (const u16*)(p.ws + OFF_GB) + (long)tok * 1024;
  {
    uint4 a = *(const uint4*)((const u16*)(p.ws + OFF_QB) + (long)tok * 512 + lane * 8);
    float v[8] = {bflo(a.x), bfhi(a.x), bflo(a.y), bfhi(a.y), bflo(a.z), bfhi(a.z), bflo(a.w), bfhi(a.w)};
    float ssq = 0.f;
#pragma unroll
    for (int j = 0; j < 8; ++j) ssq += v[j] * v[j];
    ssq = wave_sum(ssq);
    float r = rsqrtf(ssq * (1.f / 512.f) + 1e-6f);
    uint4 g = *(const uint4*)(Gb + lane * 8);
    float sg[8] = {bflo(g.x), bfhi(g.x), bflo(g.y), bfhi(g.y), bflo(g.z), bfhi(g.z), bflo(g.w), bfhi(g.w)};
    float4 n0 = *(const float4*)(p.gna + lane * 8), n1 = *(const float4*)(p.gna + lane * 8 + 4);
    float gn[8] = {n0.x, n0.y, n0.z, n0.w, n1.x, n1.y, n1.z, n1.w};
    float o[8];
#pragma unroll
    for (int j = 0; j < 8; ++j) o[j] = v[j] * r * gn[j] * sg[j];
    uint4 w; w.x = pack2(o[0], o[1]); w.y = pack2(o[2], o[3]); w.z = pack2(o[4], o[5]); w.w = pack2(o[6], o[7]);
    *(uint4*)(mixed + lane * 8) = w;
  }
}

#define ZSTR 272
__device__ __forceinline__ void mixed_hyena_128(const Params& p, int tok0, char* smem) {
  int tid_o = threadIdx.x; asm volatile("" : "+v"(tid_o));
  const int tid = tid_o;
  const u16* z2 = (const u16*)(p.ws + OFF_Z2T);
  float* ssq = (float*)(smem + 512 * ZSTR);
  __syncthreads();
#pragma unroll 4
  for (int it = 0; it < 16; ++it) {
    int id = it * 512 + tid; int row = id >> 4, part = id & 15;
    *(uint4*)(smem + row * ZSTR + part * 16) = *(const uint4*)(z2 + (long)row * NTOK + tok0 + part * 8);
  }
  __syncthreads();
  const int tk = tid & 127, cg = tid >> 7;
  const char* zc = smem + (cg * 128) * ZSTR + tk * 2;
  float acc = 0.f;
#pragma unroll 8
  for (int c = 0; c < 128; ++c) { float v = bf2f(*(const u16*)(zc + c * ZSTR)); acc += v * v; }
  ssq[cg * 128 + tk] = acc;
  __syncthreads();
  const float tot = ssq[tk] + ssq[128 + tk] + ssq[256 + tk] + ssq[384 + tk];
  const float r = rsqrtf(tot * (1.f / 512.f) + 1e-6f);
  const int tok = tok0 + tk;
  const u16* Gb = (const u16*)(p.ws + OFF_GB) + (long)tok * 1024 + 512 + cg * 128;
  u16* mixed = (u16*)(p.ws + OFF_MIXED) + (long)tok * 1024 + 512 + cg * 128;
  const float* gn = p.gnh + cg * 128;
#pragma unroll 8
  for (int i = 0; i < 16; ++i) {
    uint4 g = *(const uint4*)(Gb + i * 8);
    float sg[8] = {bflo(g.x), bfhi(g.x), bflo(g.y), bfhi(g.y), bflo(g.z), bfhi(g.z), bflo(g.w), bfhi(g.w)};
    float o[8];
#pragma unroll
    for (int j = 0; j < 8; ++j) o[j] = bf2f(*(const u16*)(zc + (i * 8 + j) * ZSTR)) * r * gn[i * 8 + j] * sg[j];
    uint4 wv; wv.x = pack2(o[0], o[1]); wv.y = pack2(o[2], o[3]); wv.z = pack2(o[4], o[5]); wv.w = pack2(o[6], o[7]);
    *(uint4*)(mixed + i * 8) = wv;
  }
}

__device__ __forceinline__ void ln_row(const Params& p, int tok, int lane) {
  float* row = p.out + (long)tok * 1024;
  float4 v[4];
  float s = 0.f;
#pragma unroll
  for (int q = 0; q < 4; ++q) { v[q] = *(const float4*)(row + q * 256 + lane * 4); s += v[q].x + v[q].y + v[q].z + v[q].w; }
  s = wave_sum(s);
  float mu = s * (1.f / 1024.f);
  float ss = 0.f;
#pragma unroll
  for (int q = 0; q < 4; ++q) {
    float a = v[q].x - mu, b = v[q].y - mu, c = v[q].z - mu, d = v[q].w - mu;
    ss += a * a + b * b + c * c + d * d;
  }
  ss = wave_sum(ss);
  float rstd = rsqrtf(ss * (1.f / 1024.f) + 1e-5f);
#pragma unroll
  for (int q = 0; q < 4; ++q) {
    float4 g = *(const float4*)(p.lng + q * 256 + lane * 4), b = *(const float4*)(p.lnb + q * 256 + lane * 4);
    float4 o;
    o.x = (v[q].x - mu) * rstd * g.x + b.x; o.y = (v[q].y - mu) * rstd * g.y + b.y;
    o.z = (v[q].z - mu) * rstd * g.z + b.z; o.w = (v[q].w - mu) * rstd * g.w + b.w;
    *(float4*)(row + q * 256 + lane * 4) = o;
  }
}


__device__ __forceinline__ void ln_row16(const Params& p, int tok, int lane) {
  const u16* hrow = (const u16*)(p.ws + OFF_GB) + (long)tok * 1024;
  float* orow = p.out + (long)tok * 1024;
  const float* xrow = (tok < 32768) ? (p.x0 + (long)tok * 1024) : (p.x1 + (long)(tok - 32768) * 1024);
  const float alpha = 1.189207115002721f;
  float v[16];
  float s = 0.f;
#pragma unroll
  for (int q = 0; q < 2; ++q) {
    uint4 a = *(const uint4*)(hrow + q * 512 + lane * 8);
    v[8 * q + 0] = bflo(a.x); v[8 * q + 1] = bfhi(a.x); v[8 * q + 2] = bflo(a.y); v[8 * q + 3] = bfhi(a.y);
    v[8 * q + 4] = bflo(a.z); v[8 * q + 5] = bfhi(a.z); v[8 * q + 6] = bflo(a.w); v[8 * q + 7] = bfhi(a.w);
    const float4 x0v = *(const float4*)(xrow + q * 512 + lane * 8), x1v = *(const float4*)(xrow + q * 512 + lane * 8 + 4);
    v[8 * q + 0] += alpha * x0v.x; v[8 * q + 1] += alpha * x0v.y; v[8 * q + 2] += alpha * x0v.z; v[8 * q + 3] += alpha * x0v.w;
    v[8 * q + 4] += alpha * x1v.x; v[8 * q + 5] += alpha * x1v.y; v[8 * q + 6] += alpha * x1v.z; v[8 * q + 7] += alpha * x1v.w;
  }
#pragma unroll
  for (int j = 0; j < 16; ++j) s += v[j];
  s = wave_sum(s);
  const float mu = s * (1.f / 1024.f);
  float ss = 0.f;
#pragma unroll
  for (int j = 0; j < 16; ++j) { float d = v[j] - mu; ss += d * d; }
  ss = wave_sum(ss);
  const float rstd = rsqrtf(ss * (1.f / 1024.f) + 1e-5f);
#pragma unroll
  for (int q = 0; q < 2; ++q)
#pragma unroll
    for (int hh = 0; hh < 2; ++hh) {
      const int c = q * 512 + lane * 8 + hh * 4;
      float4 g = *(const float4*)(p.lng + c), b = *(const float4*)(p.lnb + c);
      float4 o;
      o.x = (v[8 * q + 4 * hh + 0] - mu) * rstd * g.x + b.x; o.y = (v[8 * q + 4 * hh + 1] - mu) * rstd * g.y + b.y;
      o.z = (v[8 * q + 4 * hh + 2] - mu) * rstd * g.z + b.z; o.w = (v[8 * q + 4 * hh + 3] - mu) * rstd * g.w + b.w;
      *(float4*)(orow + c) = o;
    }
}

__global__ void __launch_bounds__(512) k_ln(Params p) {
  int tok = blockIdx.x * 8 + (threadIdx.x >> 6);
  ln_row(p, tok, threadIdx.x & 63);
}

#define LDSROW 144
#define TILEB (256 * LDSROW)
#define GEMM_LDS (4 * TILEB)

template <class Epi>
__device__ __forceinline__ void gemm_tile(const u16* __restrict__ A, long lda, const u16* __restrict__ B, long ldb,
                                          int K, char* smem, Epi& epi) {
  const int tid = threadIdx.x, lane = tid & 63, w = tid >> 6, wm = w >> 2, wn = w & 3;
  const int l31 = lane & 31, h = lane >> 5;
  f32x16 acc[4][2];
#pragma unroll
  for (int mi = 0; mi < 4; ++mi)
#pragma unroll
    for (int ni = 0; ni < 2; ++ni)
#pragma unroll
      for (int j = 0; j < 16; ++j) acc[mi][ni][j] = 0.f;
  uint4 ra0, ra1, ra2, ra3, rb0, rb1, rb2, rb3;
  const int srow = tid >> 3, skc = tid & 7;
  const u16* Ag = A + (long)srow * lda + skc * 8;
  const u16* Bg = B + (long)srow * ldb + skc * 8;
  const int soff = srow * LDSROW + skc * 16;
  const int nk = K >> 6;
#define GLD(kk) do { \
    ra0 = *(const uint4*)(Ag + (kk)); ra1 = *(const uint4*)(Ag + 64 * lda + (kk)); ra2 = *(const uint4*)(Ag + 128 * lda + (kk)); ra3 = *(const uint4*)(Ag + 192 * lda + (kk)); \
    rb0 = *(const uint4*)(Bg + (kk)); rb1 = *(const uint4*)(Bg + 64 * ldb + (kk)); rb2 = *(const uint4*)(Bg + 128 * ldb + (kk)); rb3 = *(const uint4*)(Bg + 192 * ldb + (kk)); } while (0)
#define SST(d) do { \
    *(uint4*)((d) + soff) = ra0; *(uint4*)((d) + soff + 64 * LDSROW) = ra1; *(uint4*)((d) + soff + 128 * LDSROW) = ra2; *(uint4*)((d) + soff + 192 * LDSROW) = ra3; \
    *(uint4*)((d) + TILEB + soff) = rb0; *(uint4*)((d) + TILEB + soff + 64 * LDSROW) = rb1; *(uint4*)((d) + TILEB + soff + 128 * LDSROW) = rb2; *(uint4*)((d) + TILEB + soff + 192 * LDSROW) = rb3; } while (0)
  GLD(0);
  __syncthreads();
  SST(smem);
  __syncthreads();
  for (int kt = 0; kt < nk; ++kt) {
    if (kt + 1 < nk) GLD((kt + 1) * 64);
    const char* a = smem + (kt & 1) * 2 * TILEB;
    const char* b = a + TILEB;
#pragma unroll 2
    for (int ks = 0; ks < 4; ++ks) {
      bf16x8 af[4], bfr[2];
#pragma unroll
      for (int mi = 0; mi < 4; ++mi) af[mi] = *(const bf16x8*)(a + (wm * 128 + mi * 32 + l31) * LDSROW + ks * 32 + h * 16);
#pragma unroll
      for (int ni = 0; ni < 2; ++ni) bfr[ni] = *(const bf16x8*)(b + (wn * 64 + ni * 32 + l31) * LDSROW + ks * 32 + h * 16);
#pragma unroll
      for (int mi = 0; mi < 4; ++mi)
#pragma unroll
        for (int ni = 0; ni < 2; ++ni)
          acc[mi][ni] = __builtin_amdgcn_mfma_f32_32x32x16_bf16(af[mi], bfr[ni], acc[mi][ni], 0, 0, 0);
    }
    if (kt + 1 < nk) {
      char* d = smem + ((kt + 1) & 1) * 2 * TILEB;
      SST(d);
    }
    __syncthreads();
  }
#pragma unroll
  for (int mi = 0; mi < 4; ++mi)
#pragma unroll
    for (int ni = 0; ni < 2; ++ni)
#pragma unroll
      for (int g = 0; g < 4; ++g)
        epi(wm * 128 + mi * 32 + 8 * g + 4 * h, wn * 64 + ni * 32 + l31,
            acc[mi][ni][4 * g], acc[mi][ni][4 * g + 1], acc[mi][ni][4 * g + 2], acc[mi][ni][4 * g + 3]);
}

struct EpiTokMajor {
  char* ws; int nt; int tok0;
  __device__ __forceinline__ void operator()(int m, int n, float v0, float v1, float v2, float v3) const {
    int tok = tok0 + n;
    int col = nt * 256 + m;
    u16* dst;
    if (col < 512) { dst = (u16*)(ws + OFF_QB) + (long)tok * 512 + col; v0 *= QSCALE; v1 *= QSCALE; v2 *= QSCALE; v3 *= QSCALE; }
    else if (col < 1024) dst = (u16*)(ws + OFF_KB) + (long)tok * 512 + (col - 512);
    else if (col < 1536) dst = (u16*)(ws + OFF_VB) + (long)tok * 512 + (col - 1024);
    else {
      int gc = (col < 2048) ? (col - 1536) : (512 + col - 3584);
      dst = (u16*)(ws + OFF_GB) + (long)tok * 1024 + gc;
      v0 = silu_f(v0); v1 = silu_f(v1); v2 = silu_f(v2); v3 = silu_f(v3);
    }
    uint2 o; o.x = pack2(v0, v1); o.y = pack2(v2, v3);
    *(uint2*)dst = o;
  }
};
struct EpiChanMajor {
  char* ws; int ch0; int tok0;
  __device__ __forceinline__ void operator()(int m, int n, float v0, float v1, float v2, float v3) const {
    u16* dst = (u16*)(ws + OFF_UT) + (long)(ch0 + n) * NTOK + tok0 + m;
    uint2 o; o.x = pack2(v0, v1); o.y = pack2(v2, v3);
    *(uint2*)dst = o;
  }
};

__device__ void phase1(const Params& p, char* smem) {
  const u16* xb = (const u16*)((char*)p.out + OFF_XB);
  const u16* wb = (const u16*)((char*)p.out + OFF_WBIN);
  for (int mt = blockIdx.x; mt < 256; mt += gridDim.x) {
    const int tok0 = mt * 256;
    for (int nt = 0; nt < 16; ++nt) {
      if (nt >= 8 && nt < 14) {
        EpiChanMajor e{p.ws, (nt - 8) * 256, tok0};
        gemm_tile(xb + (long)tok0 * 1024, 1024, wb + (long)nt * 256 * 1024, 1024, 1024, smem, e);
      } else {
        EpiTokMajor e{p.ws, nt, tok0};
        gemm_tile(wb + (long)nt * 256 * 1024, 1024, xb + (long)tok0 * 1024, 1024, 1024, smem, e);
      }
    }
  }
}
__global__ void __launch_bounds__(512) k_phase1(Params p) {
  extern __shared__ __attribute__((aligned(16))) char smem[];
  phase1(p, smem);
}

struct EpiOut {
  const float* x0; const float* x1; float* out; int ct; int tok0;
  __device__ __forceinline__ void operator()(int m, int n, float v0, float v1, float v2, float v3) const {
    int tok = tok0 + n, col = ct * 256 + m;
    const float* xr = (tok < 32768) ? (x0 + (long)tok * 1024) : (x1 + (long)(tok - 32768) * 1024);
    float4 xv = *(const float4*)(xr + col);
    const float alpha = 1.189207115002721f;
    float4 o; o.x = alpha * xv.x + v0; o.y = alpha * xv.y + v1; o.z = alpha * xv.z + v2; o.w = alpha * xv.w + v3;
    *(float4*)(out + (long)tok * 1024 + col) = o;
  }
};

__device__ void phase4(const Params& p, char* smem) {
  const u16* mixed = (const u16*)(p.ws + OFF_MIXED);
  const u16* wb = (const u16*)(p.ws + OFF_WBOUT);
  const int lane = threadIdx.x & 63, w = threadIdx.x >> 6;
  for (int mt = blockIdx.x; mt < 256; mt += gridDim.x) {
    const int tok0 = mt * 256;
    mixed_hyena_128(p, tok0, smem);
    mixed_hyena_128(p, tok0 + 128, smem);
    for (int i = 0; i < 32; ++i) mixed_row(p, tok0 + w * 32 + i, lane);
    __syncthreads();
    for (int ct = 0; ct < 4; ++ct) {
      EpiOut e{p.x0, p.x1, p.out, ct, tok0};
      gemm_tile(wb + (long)ct * 256 * 1024, 1024, mixed + (long)tok0 * 1024, 1024, 1024, smem, e);
    }
    __syncthreads();
    for (int i = 0; i < 32; ++i) ln_row(p, tok0 + w * 32 + i, lane);
  }
}
__global__ void __launch_bounds__(512) k_phase4(Params p) {
  extern __shared__ __attribute__((aligned(16))) char smem[];
  phase4(p, smem);
}

namespace pg8 {
#define PG8_LAS __attribute__((address_space(3)))
typedef unsigned short bf16_t;
typedef short bf16x8 __attribute__((ext_vector_type(8)));
typedef float f32x4 __attribute__((ext_vector_type(4)));
typedef unsigned u32x4 __attribute__((ext_vector_type(4)));
constexpr int BM = 256, BK = 64, HALF = 128, HTB = HALF * BK * 2  , STAGE_BYTES = 8 * HTB, NXCD = 8, WGM = 8;

__host__ __device__ __forceinline__ int lds_byte(int r, int c) { const int st = (r >> 4) * 2 + (c >> 5), rr = r & 15, cc = c & 31, ob = rr * 64 + cc * 2; return st * 1024 + (ob ^ (((ob >> 9) & 1) << 5)); }
__host__ __device__ __forceinline__ void stage_rc(int b, int& R, int& C) { const int st = b / 1024, sb = b % 1024, swz = sb ^ (((sb >> 9) & 1) << 5); R = (st >> 1) * 16 + swz / 64; C = (st & 1) * 32 + (swz % 64) / 2; }
__host__ __device__ __forceinline__ int perm32(int rho) { const int n = rho >> 4, i = rho & 15; return 8 * (i >> 2) + 4 * n + (i & 3); }
struct Unit { int pm, pn; };
struct Gemm { const bf16_t* A; const bf16_t* Bt; int M, N, K; };
__device__ __forceinline__ unsigned cvt_pk_bf16(float lo, float hi) { unsigned r; asm volatile("v_cvt_pk_bf16_f32 %0, %1, %2" : "=v"(r) : "v"(lo), "v"(hi)); return r; }
template <class Epi, class Sched, bool STAMP = false>
__device__ __forceinline__ void gemm_phase(PG8_LAS unsigned char* lds, const Gemm g, const Sched& S, const Epi& E, unsigned long long* stamps) {
    int tid_o = threadIdx.x; asm volatile("" : "+v"(tid_o));
    const int tid = tid_o, wid = __builtin_amdgcn_readfirstlane(tid >> 6), lane = tid & 63, wr = wid >> 2, wc = wid & 3, fr = lane & 15, fq = lane >> 4;
    const int K = g.K, nt = K / BK;
    int ts_lo = 0, ts_hi = 0, nts = 0; const unsigned long long rt_entry = STAMP ? 0ull : 0ull;
#define PG8_STAMP() do { if (STAMP && wid == 0 && nts < 64) { const unsigned long long _c = 0ull; \
        ts_lo = (lane == nts) ? (int)(unsigned)_c : ts_lo; ts_hi = (lane == nts) ? (int)(unsigned)(_c >> 32) : ts_hi; ++nts; } } while (0)
    PG8_STAMP();
    unsigned voffA[2], voffB[2];
#pragma unroll
    for (int i = 0; i < 2; ++i) { int R, C; stage_rc(tid * 16 + i * 8192, R, C); const int Rb = Epi::PERM ? ((R & ~31) + perm32(R & 31)) : R;
        voffA[i] = (unsigned)(R * K + C) * 2u; voffB[i] = (unsigned)(Rb * K + C) * 2u; }
    const size_t kstep = (size_t)(BK * 2);
    const size_t hstep = (size_t)HALF * K * 2;
    const size_t tstep = 2 * hstep;
    const unsigned ldsw = (unsigned)wid * 1024u;
    const int aoff = lds_byte(wr * 64 + fr, fq * 8), boff = lds_byte(wc * 32 + fr, fq * 8);
#define PG8_SA(b, h) (((b) * 2 + (h)) * HTB)
#define PG8_SB(b, h) ((4 + (b) * 2 + (h)) * HTB)
#define PG8_STAGE(bufoff, gbase, voff) do { _Pragma("unroll") for (int _i = 0; _i < 2; ++_i) \
        __builtin_amdgcn_global_load_lds((const unsigned*)((const char*)(gbase) + (voff)[_i]), (PG8_LAS unsigned*)(lds + (bufoff) + ldsw + _i * 8192), 16, 0, 0); } while (0)
#define PG8_LDA(dst, b, h) do { _Pragma("unroll") for (int m = 0; m < 4; ++m) _Pragma("unroll") for (int k = 0; k < 2; ++k) dst[m][k] = *(const PG8_LAS bf16x8*)(lds + PG8_SA(b, h) + aoff + m * 2048 + k * 1024); } while (0)
#define PG8_LDB(dst, b, h) do { _Pragma("unroll") for (int n = 0; n < 2; ++n) _Pragma("unroll") for (int k = 0; k < 2; ++k) dst[n][k] = *(const PG8_LAS bf16x8*)(lds + PG8_SB(b, h) + boff + n * 2048 + k * 1024); } while (0)
#define PG8_MMA(ai, bj, At, Bt) do { __builtin_amdgcn_s_setprio(1); _Pragma("unroll") for (int m = 0; m < 4; ++m) _Pragma("unroll") for (int n = 0; n < 2; ++n) _Pragma("unroll") for (int k = 0; k < 2; ++k) \
        acc[ai][bj][m][n] = __builtin_amdgcn_mfma_f32_16x16x32_bf16(Bt[n][k], At[m][k], acc[ai][bj][m][n], 0, 0, 0); __builtin_amdgcn_s_setprio(0); } while (0)
#define PG8_WAIT_V(n) asm volatile("s_waitcnt vmcnt(" #n ")" ::: "memory")
#define PG8_WAIT_L(n) asm volatile("s_waitcnt lgkmcnt(" #n ")" ::: "memory")
#define PG8_BAR __builtin_amdgcn_s_barrier()
#define PG8_SCHED __builtin_amdgcn_sched_barrier(0)
    Unit cur, nxt; int ui = 0;
    if (!S.next(0, cur)) return;
    f32x4 acc[2][2][4][2];
#pragma unroll
    for (int a = 0; a < 2; ++a)
#pragma unroll
        for (int b = 0; b < 2; ++b)
#pragma unroll
            for (int m = 0; m < 4; ++m)
#pragma unroll
                for (int n = 0; n < 2; ++n) acc[a][b][m][n] = (f32x4){0.f, 0.f, 0.f, 0.f};
    bf16x8 At[4][2], B0[2][2], B1[2][2];
    const char* cA = (const char*)g.A + (size_t)cur.pm * tstep; const char* cB = (const char*)g.Bt + (size_t)cur.pn * tstep;
    S.a_ready(cur);
    PG8_STAGE(PG8_SB(0, 0), cB, voffB); PG8_STAGE(PG8_SA(0, 0), cA, voffA); PG8_STAGE(PG8_SB(0, 1), cB + hstep, voffB); PG8_STAGE(PG8_SA(0, 1), cA + hstep, voffA);
    if (wr == 1) PG8_BAR;
    PG8_WAIT_V(4); PG8_BAR;
    PG8_STAGE(PG8_SB(1, 0), cB + kstep, voffB); PG8_STAGE(PG8_SA(1, 0), cA + kstep, voffA); PG8_STAGE(PG8_SB(1, 1), cB + hstep + kstep, voffB);
    PG8_WAIT_V(6); PG8_BAR;
    PG8_STAMP();
    for (;;) {
        const bool has_next = S.next(ui + 1, nxt);
        const char* nA = has_next ? (const char*)g.A + (size_t)nxt.pm * tstep : cA; const char* nB = has_next ? (const char*)g.Bt + (size_t)nxt.pn * tstep : cB;
        for (int t = 0; t < nt; t += 2) {
            const bool last = (t == nt - 2);
            const char* a1 = cA + (size_t)(t + 1) * kstep;
            const char* a2 = last ? nA : cA + (size_t)(t + 2) * kstep; const char* b2 = last ? nB : cB + (size_t)(t + 2) * kstep;
            const char* a3 = a2 + kstep; const char* b3 = b2 + kstep;
            if (last && has_next) S.a_ready(nxt);
            PG8_LDB(B0, 0, 0); PG8_SCHED; PG8_LDA(At, 0, 0); PG8_STAGE(PG8_SA(1, 1), a1 + hstep, voffA);
            PG8_WAIT_L(8); PG8_BAR; PG8_WAIT_L(0); PG8_MMA(0, 0, At, B0); PG8_BAR; PG8_SCHED;
            PG8_LDB(B1, 0, 1); PG8_STAGE(PG8_SB(0, 0), b2, voffB);
            PG8_BAR; PG8_WAIT_L(0); PG8_MMA(0, 1, At, B1); PG8_BAR;
            PG8_LDA(At, 0, 1); PG8_STAGE(PG8_SA(0, 0), a2, voffA);
            PG8_BAR; PG8_WAIT_L(0); PG8_MMA(1, 0, At, B0); PG8_BAR; PG8_SCHED;
            PG8_STAGE(PG8_SB(0, 1), b2 + hstep, voffB);
            PG8_WAIT_V(6); PG8_BAR; PG8_MMA(1, 1, At, B1); PG8_BAR;
            PG8_LDB(B0, 1, 0); PG8_SCHED; PG8_LDA(At, 1, 0); PG8_STAGE(PG8_SA(0, 1), a2 + hstep, voffA);
            PG8_WAIT_L(8); PG8_BAR; PG8_WAIT_L(0); PG8_MMA(0, 0, At, B0); PG8_BAR; PG8_SCHED;
            PG8_LDB(B1, 1, 1); PG8_STAGE(PG8_SB(1, 0), b3, voffB);
            PG8_BAR; PG8_WAIT_L(0); PG8_MMA(0, 1, At, B1); PG8_BAR;
            PG8_LDA(At, 1, 1); PG8_STAGE(PG8_SA(1, 0), a3, voffA);
            PG8_BAR; PG8_WAIT_L(0); PG8_MMA(1, 0, At, B0); PG8_BAR; PG8_SCHED;
            PG8_STAGE(PG8_SB(1, 1), b3 + hstep, voffB);
            PG8_WAIT_V(6); PG8_BAR; PG8_MMA(1, 1, At, B1); PG8_BAR;
        }
        PG8_STAMP();
        if constexpr (!Epi::AFTER_DRAIN) { E(acc, cur, wr, wc, fr, fq); S.done(cur); }
        PG8_STAMP();
        if (!has_next) break;
#pragma unroll
        for (int a = 0; a < 2; ++a)
#pragma unroll
            for (int b = 0; b < 2; ++b)
#pragma unroll
                for (int m = 0; m < 4; ++m)
#pragma unroll
                    for (int n = 0; n < 2; ++n) acc[a][b][m][n] = (f32x4){0.f, 0.f, 0.f, 0.f};
        cur = nxt; cA = nA; cB = nB; ++ui;
    }
    PG8_WAIT_V(0);
    if (wr == 0) PG8_BAR;
    PG8_BAR;
    if constexpr (Epi::AFTER_DRAIN) { E.fused(acc, cur, wr, wc, fr, fq, lds, wid, lane); S.done(cur); }
    PG8_STAMP();
    if (STAMP && wid == 0) { stamps[lane] = lane < nts ? (((unsigned long long)(unsigned)ts_hi << 32) | (unsigned)ts_lo) : 0ull;
        if (lane == 62) stamps[62] = rt_entry; if (lane == 63) stamps[63] = 0ull; }
#undef PG8_STAMP
#undef PG8_SA
#undef PG8_SB
#undef PG8_STAGE
#undef PG8_LDA
#undef PG8_LDB
#undef PG8_MMA
#undef PG8_WAIT_V
#undef PG8_WAIT_L
#undef PG8_BAR
#undef PG8_SCHED
}
}

struct SchedRowTile {
  int pm; int n; int base; int skip_from; int skip_add;
  __device__ __forceinline__ bool next(int i, pg8::Unit& u) const { if (i >= n) return false; u.pm = pm; u.pn = base + i + (i >= skip_from ? skip_add : 0); return true; }
  __device__ __forceinline__ void a_ready(const pg8::Unit&) const {}
  __device__ __forceinline__ void done(const pg8::Unit&) const {}
};
struct SchedColTile {
  int pn; int n;
  __device__ __forceinline__ bool next(int i, pg8::Unit& u) const { if (i >= n) return false; u.pm = i; u.pn = pn; return true; }
  __device__ __forceinline__ void a_ready(const pg8::Unit&) const {}
  __device__ __forceinline__ void done(const pg8::Unit&) const {}
};


struct SchedXcd {
  int nM, nN, nwg, G, c, skip_from, skip_add;
  __device__ __forceinline__ bool next(int i, pg8::Unit& u) const {
    const long L = (long)i * G + c; if (L >= nwg) return false;
    int wgid = (int)L; { const int q = nwg / 8, r = nwg % 8, xcd = wgid % 8, off = wgid / 8; wgid = (xcd < r ? xcd * (q + 1) : r * (q + 1) + (xcd - r) * q) + off; }
    const int nig = 8 * nN, gid = wgid / nig, fm = gid * 8, gsz = (nM - fm) < 8 ? (nM - fm) : 8;
    u.pm = fm + ((wgid % nig) % gsz);
    const int pn = (wgid % nig) / gsz;
    u.pn = pn + (pn >= skip_from ? skip_add : 0);
    return true;
  }
  __device__ __forceinline__ void a_ready(const pg8::Unit&) const {}
  __device__ __forceinline__ void done(const pg8::Unit&) const {}
};

struct EpiProjTok {
  static constexpr bool PERM = true, AFTER_DRAIN = false;
  char* ws;
  __device__ __forceinline__ void operator()(const pg8::f32x4 (&acc)[2][2][4][2], const pg8::Unit& u, int wr, int wc, int fr, int fq) const {
    int row0 = u.pm * 256 + wr * 64 + fr;
    asm volatile("" : "+v"(row0));
    const int pn = u.pn;
    u16* base; int ldc; int cofs; int mode;
    if (pn < 2) { base = (u16*)(ws + OFF_QB); ldc = 512; cofs = pn * 256; mode = 1; }
    else if (pn < 4) { base = (u16*)(ws + OFF_KB); ldc = 512; cofs = (pn - 2) * 256; mode = 0; }
    else if (pn < 6) { base = (u16*)(ws + OFF_VB); ldc = 512; cofs = (pn - 4) * 256; mode = 0; }
    else if (pn < 8) { base = (u16*)(ws + OFF_GB); ldc = 1024; cofs = (pn - 6) * 256; mode = 2; }
    else { base = (u16*)(ws + OFF_GB); ldc = 1024; cofs = 512 + (pn - 14) * 256; mode = 2; }
    const int col0 = cofs + wc * 32 + 8 * fq;
#pragma unroll
    for (int ai = 0; ai < 2; ++ai)
#pragma unroll
      for (int m = 0; m < 4; ++m) {
        u16* rowp = base + (size_t)(row0 + ai * 128 + m * 16) * ldc + col0;
#pragma unroll
        for (int bj = 0; bj < 2; ++bj) {
          pg8::f32x4 v0 = acc[ai][bj][m][0], v1 = acc[ai][bj][m][1];
          if (mode == 1) { v0 *= QSCALE; v1 *= QSCALE; }
          if (mode == 2) {
#pragma unroll
            for (int j = 0; j < 4; ++j) { v0[j] = silu_f(v0[j]); v1[j] = silu_f(v1[j]); }
          }
          pg8::u32x4 w; w.x = pg8::cvt_pk_bf16(v0[0], v0[1]); w.y = pg8::cvt_pk_bf16(v0[2], v0[3]); w.z = pg8::cvt_pk_bf16(v1[0], v1[1]); w.w = pg8::cvt_pk_bf16(v1[2], v1[3]);
          *(pg8::u32x4*)(rowp + bj * 128) = w;
        }
      }
  }
};
struct EpiProjChan {
  static constexpr bool PERM = true, AFTER_DRAIN = false;
  char* ws;
  __device__ __forceinline__ void operator()(const pg8::f32x4 (&acc)[2][2][4][2], const pg8::Unit& u, int wr, int wc, int fr, int fq) const {
    int row0 = u.pm * 256 + wr * 64 + fr;
    int col0 = u.pn * 256 + wc * 32 + 8 * fq;
    asm volatile("" : "+v"(row0), "+v"(col0));
    u16* base = (u16*)(ws + OFF_UT);
#pragma unroll
    for (int ai = 0; ai < 2; ++ai)
#pragma unroll
      for (int m = 0; m < 4; ++m) {
        u16* rowp = base + (size_t)(row0 + ai * 128 + m * 16) * NTOK + col0;
#pragma unroll
        for (int bj = 0; bj < 2; ++bj) {
          pg8::f32x4 v0 = acc[ai][bj][m][0], v1 = acc[ai][bj][m][1];
          pg8::u32x4 w; w.x = pg8::cvt_pk_bf16(v0[0], v0[1]); w.y = pg8::cvt_pk_bf16(v0[2], v0[3]); w.z = pg8::cvt_pk_bf16(v1[0], v1[1]); w.w = pg8::cvt_pk_bf16(v1[2], v1[3]);
          *(pg8::u32x4*)(rowp + bj * 128) = w;
        }
      }
  }
};
struct EpiOutF32 {
  static constexpr bool PERM = false, AFTER_DRAIN = false;
  const float* x0; const float* x1; float* out;
  __device__ __forceinline__ void operator()(const pg8::f32x4 (&acc)[2][2][4][2], const pg8::Unit& u, int wr, int wc, int fr, int fq) const {
    int row0 = u.pm * 256 + wr * 64 + fr, col0 = u.pn * 256 + wc * 32 + 4 * fq;
    asm volatile("" : "+v"(row0), "+v"(col0));
    const float alpha = 1.189207115002721f;
#pragma unroll
    for (int ai = 0; ai < 2; ++ai)
#pragma unroll
      for (int m = 0; m < 4; ++m) {
        const int tok = row0 + ai * 128 + m * 16;
        const float* xr = ((tok < 32768) ? (x0 + (size_t)tok * 1024) : (x1 + (size_t)(tok - 32768) * 1024)) + col0;
        float* rowp = out + (size_t)tok * 1024 + col0;
#pragma unroll
        for (int bj = 0; bj < 2; ++bj)
#pragma unroll
          for (int n = 0; n < 2; ++n) {
            pg8::f32x4 xv = *(const pg8::f32x4*)(xr + bj * 128 + n * 16);
            *(pg8::f32x4*)(rowp + bj * 128 + n * 16) = acc[ai][bj][m][n] + alpha * xv;
          }
        __builtin_amdgcn_sched_barrier(0);
      }
  }
};


struct EpiOutH16 {
  static constexpr bool PERM = true, AFTER_DRAIN = false;
  const float* x0; const float* x1; char* ws;
  __device__ __forceinline__ void operator()(const pg8::f32x4 (&acc)[2][2][4][2], const pg8::Unit& u, int wr, int wc, int fr, int fq) const {
    int row0 = u.pm * 256 + wr * 64 + fr, col0 = u.pn * 256 + wc * 32 + 8 * fq;
    asm volatile("" : "+v"(row0), "+v"(col0));
    u16* hb = (u16*)(ws + OFF_GB);
#pragma unroll
    for (int ai = 0; ai < 2; ++ai)
#pragma unroll
      for (int m = 0; m < 4; ++m) {
        const int tok = row0 + ai * 128 + m * 16;
        u16* rowp = hb + (size_t)tok * 1024 + col0;
#pragma unroll
        for (int bj = 0; bj < 2; ++bj) {
          pg8::f32x4 v0 = acc[ai][bj][m][0], v1 = acc[ai][bj][m][1];
          pg8::u32x4 w; w.x = pg8::cvt_pk_bf16(v0[0], v0[1]); w.y = pg8::cvt_pk_bf16(v0[2], v0[3]); w.z = pg8::cvt_pk_bf16(v1[0], v1[1]); w.w = pg8::cvt_pk_bf16(v1[2], v1[3]);
          *(pg8::u32x4*)(rowp + bj * 128) = w;
        }
        __builtin_amdgcn_sched_barrier(0);
      }
  }
};

__device__ __forceinline__ void phase1_v8(const Params& p, char* smem) {
  const pg8::bf16_t* xb = (const pg8::bf16_t*)((char*)p.out + OFF_XB);
  const pg8::bf16_t* wb = (const pg8::bf16_t*)((char*)p.out + OFF_WBIN);
  PG8_LAS unsigned char* lds = (PG8_LAS unsigned char*)smem;
  __syncthreads();
  {
    pg8::Gemm g{xb, wb, NTOK, 4096, 1024};
    SchedXcd S{256, 10, 2560, (int)gridDim.x, (int)blockIdx.x, 8, 6};
    EpiProjTok E{p.ws};
    pg8::gemm_phase<EpiProjTok, SchedXcd, false>(lds, g, S, E, nullptr);
  }
  __syncthreads();
  {
    pg8::Gemm g{wb + (size_t)2048 * 1024, xb, 1536, NTOK, 1024};
    SchedXcd S{6, 256, 1536, (int)gridDim.x, (int)blockIdx.x, 1 << 30, 0};
    EpiProjChan E{p.ws};
    pg8::gemm_phase<EpiProjChan, SchedXcd, false>(lds, g, S, E, nullptr);
  }
}

__device__ __forceinline__ void phase4_v8(const Params& p, char* smem) {
  const pg8::bf16_t* mixed = (const pg8::bf16_t*)(p.ws + OFF_MIXED);
  const pg8::bf16_t* wb = (const pg8::bf16_t*)g_wbout;
  PG8_LAS unsigned char* lds = (PG8_LAS unsigned char*)smem;
  const int lane = threadIdx.x & 63, w = threadIdx.x >> 6;
  for (int mt = blockIdx.x; mt < 256; mt += gridDim.x) {
    const int tok0 = mt * 256;
    mixed_hyena_128(p, tok0, smem);
    mixed_hyena_128(p, tok0 + 128, smem);
    { int lane1 = lane, w1 = w; asm volatile("" : "+v"(lane1), "+v"(w1));
      _Pragma("unroll 8") for (int i = 0; i < 32; ++i) mixed_row(p, tok0 + w1 * 32 + i, lane1); }
    __syncthreads();
    {
      pg8::Gemm g{mixed, wb, NTOK, 1024, 1024};
      SchedRowTile S{mt, 4, 0, 99, 0};
      EpiOutH16 E{p.x0, p.x1, p.ws};
      pg8::gemm_phase<EpiOutH16, SchedRowTile, false>(lds, g, S, E, nullptr);
    }
    __syncthreads();
    int lane2 = lane, w2 = w;
    asm volatile("" : "+v"(lane2), "+v"(w2));
#pragma unroll 8
    for (int i = 0; i < 32; ++i) ln_row16(p, tok0 + w2 * 32 + i, lane2);
  }
}

#define HY_US_BYTES 85760
#define HY_ZOFF 85760
#define HY_ZBYTES 5248
#define HY_GRL_OFF (HY_ZOFF + HY_ZBYTES)
#define HY_LDS (HY_GRL_OFF + 65664 + 64)
#define PHYS(x) ((x) + (((x) >> 5) << 3))

__device__ __forceinline__ uint4 conv8(const u16* __restrict__ row, int tau, int t, int L, float cb, float w0, float w1, float w2) {
  uint4 raw = *(const uint4*)(row + tau);
  float v[10];
  v[0] = (t > 0) ? bf2f(row[tau - 1]) : 0.f;
  v[1] = bflo(raw.x); v[2] = bfhi(raw.x); v[3] = bflo(raw.y); v[4] = bfhi(raw.y);
  v[5] = bflo(raw.z); v[6] = bfhi(raw.z); v[7] = bflo(raw.w); v[8] = bfhi(raw.w);
  v[9] = (t + 8 < L) ? bf2f(row[tau + 8]) : 0.f;
  float o[8];
#pragma unroll
  for (int j = 0; j < 8; ++j) o[j] = cb + w0 * v[j] + w1 * v[j + 1] + w2 * v[j + 2];
  uint4 r; r.x = pack2(o[0], o[1]); r.y = pack2(o[2], o[3]); r.z = pack2(o[4], o[5]); r.w = pack2(o[6], o[7]);
  return r;
}

template <bool SAMP>
__device__ __forceinline__ void hyena_unit(const Params& p, int c, char* smem) {
  constexpr int L = SAMP ? 16384 : 4096;
  constexpr int LSH = SAMP ? 14 : 12;
  constexpr int NB = SAMP ? 2 : 8;
  constexpr int P = SAMP ? 512 : 128;
  constexpr int LG = SAMP ? LG_S : LG_P;
  constexpr int BS = L + P;
  constexpr int TB = P * 5 / 2;
  constexpr int tokbase = SAMP ? 32768 : 0;
  const int tid = threadIdx.x, lane = tid & 63;
  const int w = __builtin_amdgcn_readfirstlane(tid >> 6);
  u16* us = (u16*)smem;
  u16* grl = (u16*)(smem + HY_GRL_OFF);
  const u16* UT = (const u16*)(p.ws + OFF_UT);
  constexpr int NF = (LG / 8 + 511) / 512;
  uint4 fr[NF];
#pragma unroll
  for (int k = 0; k < NF; ++k) fr[k] = make_uint4(0, 0, 0, 0);
#pragma unroll 1
  for (int order = 0; order < 2; ++order) {
  const u16* GRg = (const u16*)((char*)p.out + (SAMP ? OFF_GRS : OFF_GRP)) + (long)(order * 512 + c) * LG;
  const u16* usrc = (order == 0) ? (UT + (long)c * NTOK + tokbase)
                                 : ((const u16*)((char*)p.out + OFF_Z1T) + (long)c * NTOK + tokbase);
  const int gch = 512 * (order + 1) + c;
  const u16* gsrc = UT + (long)gch * NTOK + tokbase;
  u16* dst = ((order == 0) ? (u16*)((char*)p.out + OFF_Z1T) : (u16*)(p.ws + OFF_Z2T)) + (long)c * NTOK + tokbase;

  __syncthreads();
  if (order == 0) {
#pragma unroll
    for (int k = 0; k < NF; ++k) { int i = tid + k * 512; if (i < LG / 8) *(uint4*)(grl + i * 8) = *(const uint4*)(GRg + i * 8); }
  } else {
#pragma unroll
    for (int k = 0; k < NF; ++k) { int i = tid + k * 512; if (i < LG / 8) *(uint4*)(grl + i * 8) = fr[k]; }
  }
  if (tid < 4) *(uint4*)(grl + LG + tid * 8) = make_uint4(0, 0, 0, 0);
  if (order == 0) {
  {
    const uint4 z4 = make_uint4(0, 0, 0, 0);
    for (int i = tid; i < HY_ZBYTES / 16; i += 512) *(uint4*)(smem + HY_ZOFF + i * 16) = z4;
    for (int i = tid; i < (P >> 3); i += 512) { int x = i * 8; *(uint4*)(us + PHYS(x)) = z4; }
    for (int i = tid; i < NB * (P >> 3); i += 512) {
      int g = i / (P >> 3), r = i - g * (P >> 3);
      int x = P + g * BS + L + r * 8;
      *(uint4*)(us + PHYS(x)) = z4;
    }
  }
  {
    const float cb = p.conv_b[c], w0 = p.conv_w[c], w1 = p.conv_w[1536 + c], w2 = p.conv_w[3072 + c];
#pragma unroll
    for (int k = 0; k < 8; ++k) {
      int i = tid + k * 512;
      int tau = i * 8, b = tau >> LSH, t = tau & (L - 1);
      int x = P + b * BS + t;
      *(uint4*)(us + PHYS(x)) = conv8(usrc, tau, t, L, cb, w0, w1, w2);
    }
  }
  }
  __syncthreads();

  int lane_o = lane; asm volatile("" : "+v"(lane_o));
  const int n = lane_o & 31, h = lane_o >> 5;
  int grp, idx;
  if (n < 4) { grp = 0; idx = n; } else if (n < 12) { grp = 1; idx = n - 4; } else if (n < 16) { grp = 0; idx = n - 8; }
  else if (n < 20) { grp = 1; idx = n - 8; } else if (n < 28) { grp = 0; idx = n - 12; } else { grp = 1; idx = n - 16; }
  const int bat = SAMP ? grp : (4 * grp + (idx & 3));
  const int ii = SAMP ? idx : (idx >> 2);
  const int ebase = L + 32 - n + 8 * h;
  const unsigned sh = (unsigned)(ebase & 1) * 16u;
  f32x16 acc0, acc1, acc2, acc3;
#pragma unroll
  for (int j = 0; j < 16; ++j) { acc0[j] = 0.f; acc1[j] = 0.f; acc2[j] = 0.f; acc3[j] = 0.f; }
  const int o0 = P * 4 * w;
  const int base_hi = o0 + 4 * P - 32;
  constexpr int JN2 = P / 32;
  constexpr int NI = (L + 4 * P - 32) / 16;
  constexpr int KB = (NI + 2 * (P / 16) - 1) / (2 * (P / 16));
  constexpr int NPAIR = KB * JN2;
  constexpr int smin = -(P - 32), smaxp = L - 32;
  const int a_lane = HY_GRL_OFF + ((ebase >> 1) << 2);
  const int a_lane8 = a_lane - 2 * base_hi;
  const int b_lane = 2 * (8 * h + 40 * ii + bat * (BS * 5 / 4)) + 2 * ((-3 * P + 32) * 5 / 4);
  const int vz = HY_ZOFF;

#define HY_LD(SFX, VA, E0, E1, E2, E3, E4, IMM) do { \
    const unsigned* ga_ = (const unsigned*)(smem + (VA) + (IMM)); \
    const unsigned* gb_ = (const unsigned*)(smem + (VA) + 2 * P + (IMM)); \
    pa0##SFX = ga_[0]; pa1##SFX = ga_[1]; pa2##SFX = ga_[2]; pa3##SFX = ga_[3]; pa4##SFX = ga_[4]; \
    pb0##SFX = gb_[0]; pb1##SFX = gb_[1]; pb2##SFX = gb_[2]; pb3##SFX = gb_[3]; pb4##SFX = gb_[4]; \
    b0##SFX = *(const bf16x8*)(smem + (E0) + (IMM)); \
    b1##SFX = *(const bf16x8*)(smem + (E1) + TB + (IMM)); \
    b2##SFX = *(const bf16x8*)(smem + (E2) + 2 * TB + (IMM)); \
    b3##SFX = *(const bf16x8*)(smem + (E3) + 3 * TB + (IMM)); \
    b4##SFX = *(const bf16x8*)(smem + (E4) + 4 * TB + (IMM)); } while (0)
#define HY_AFRAG(DST, D0, D1, D2, D3, D4) do { \
    DST.u[0] = __builtin_amdgcn_alignbit(D1, D0, sh); DST.u[1] = __builtin_amdgcn_alignbit(D2, D1, sh); \
    DST.u[2] = __builtin_amdgcn_alignbit(D3, D2, sh); DST.u[3] = __builtin_amdgcn_alignbit(D4, D3, sh); } while (0)
#define HY_MMA(SFX) do { \
    union { unsigned u[4]; bf16x8 v; } Aa_, Ab_; \
    HY_AFRAG(Aa_, pa0##SFX, pa1##SFX, pa2##SFX, pa3##SFX, pa4##SFX); \
    HY_AFRAG(Ab_, pb0##SFX, pb1##SFX, pb2##SFX, pb3##SFX, pb4##SFX); \
    acc0 = __builtin_amdgcn_mfma_f32_32x32x16_bf16(Aa_.v, b0##SFX, acc0, 0, 0, 0); \
    acc1 = __builtin_amdgcn_mfma_f32_32x32x16_bf16(Aa_.v, b1##SFX, acc1, 0, 0, 0); \
    acc2 = __builtin_amdgcn_mfma_f32_32x32x16_bf16(Aa_.v, b2##SFX, acc2, 0, 0, 0); \
    acc3 = __builtin_amdgcn_mfma_f32_32x32x16_bf16(Aa_.v, b3##SFX, acc3, 0, 0, 0); \
    acc0 = __builtin_amdgcn_mfma_f32_32x32x16_bf16(Ab_.v, b1##SFX, acc0, 0, 0, 0); \
    acc1 = __builtin_amdgcn_mfma_f32_32x32x16_bf16(Ab_.v, b2##SFX, acc1, 0, 0, 0); \
    acc2 = __builtin_amdgcn_mfma_f32_32x32x16_bf16(Ab_.v, b3##SFX, acc2, 0, 0, 0); \
    acc3 = __builtin_amdgcn_mfma_f32_32x32x16_bf16(Ab_.v, b4##SFX, acc3, 0, 0, 0); } while (0)
#define HY_ADDR(K, JP) do { \
    const int sc_ = 4 * P * (K) + 64 * (JP); \
    va = a_lane8 + ((K) < KB ? sc_ : 0); \
    vb = b_lane + 5 * P * (K) + 80 * (JP); \
    const int s_ = -4 * P + 32 + 2 * P * (K) + 32 * (JP); \
    const bool ok_ = (K) < KB; \
    e0 = (ok_ && s_ >= smin && s_ <= smaxp) ? vb : vz; \
    e1 = (ok_ && s_ + P >= smin && s_ + P <= smaxp) ? vb : vz; \
    e2 = (ok_ && s_ + 2 * P >= smin && s_ + 2 * P <= smaxp) ? vb : vz; \
    e3 = (ok_ && s_ + 3 * P >= smin && s_ + 3 * P <= smaxp) ? vb : vz; \
    e4 = (ok_ && s_ + 4 * P >= smin && s_ + 4 * P <= smaxp) ? vb : vz; } while (0)
  {
    unsigned pa0x, pa1x, pa2x, pa3x, pa4x, pb0x, pb1x, pb2x, pb3x, pb4x, pa0y, pa1y, pa2y, pa3y, pa4y, pb0y, pb1y, pb2y, pb3y, pb4y,
             pa0z, pa1z, pa2z, pa3z, pa4z, pb0z, pb1z, pb2z, pb3z, pb4z;
    bf16x8 b0x, b1x, b2x, b3x, b4x, b0y, b1y, b2y, b3y, b4y, b0z, b1z, b2z, b3z, b4z;
    int va, vb, e0, e1, e2, e3, e4;
    int k = 0, jp = 0;
    static_assert(NPAIR % 3 == 0, "three rotating register sets");
#define HY_NEXTPAIR() do { jp += 1; if (jp == JN2) { jp = 0; k += 1; } HY_ADDR(k, jp); } while (0)
#define HY_STEP(CUR, TGT, IMM) do { \
      __builtin_amdgcn_sched_barrier(0); \
      HY_MMA(CUR); \
      __builtin_amdgcn_sched_barrier(0); \
      HY_LD(TGT, va, e0, e1, e2, e3, e4, IMM); } while (0)
    HY_ADDR(k, jp);
    HY_LD(x, va, e0, e1, e2, e3, e4, 0);
    HY_LD(y, va, e0, e1, e2, e3, e4, 32);
    for (int it = 0; it < NPAIR / 3; ++it) {
      HY_NEXTPAIR();
      HY_STEP(x, z, 0);
      HY_STEP(y, x, 32);
      HY_NEXTPAIR();
      HY_STEP(z, y, 0);
      HY_STEP(x, z, 32);
      HY_NEXTPAIR();
      HY_STEP(y, x, 0);
      HY_STEP(z, y, 32);
    }
  }
  __syncthreads();
  if (order == 0) {
    const u16* GRn = GRg + (long)512 * LG;
#pragma unroll
    for (int k = 0; k < NF; ++k) { int i = tid + k * 512; if (i < LG / 8) fr[k] = *(const uint4*)(GRn + i * 8); }
  }
  {
    const float cb = p.conv_b[gch], w0 = p.conv_w[gch], w1 = p.conv_w[1536 + gch], w2 = p.conv_w[3072 + gch];
#pragma unroll
    for (int k = 0; k < 8; ++k) {
      int i = tid + k * 512;
      int tau = i * 8, t = tau & (L - 1);
      *(uint4*)(grl + tau) = conv8(gsrc, tau, t, L, cb, w0, w1, w2);
    }
  }
  __syncthreads();
  const float dv = p.hyd[order * 512 + c];
#define HY_EPI(ACC, R) do { \
    _Pragma("unroll") for (int g4 = 0; g4 < 4; ++g4) { \
      int t = o0 + P * (R) + 8 * g4 + 4 * h + 32 * ii; \
      int tau = (bat << LSH) + t; \
      int ue_ = P + bat * BS + t; \
      uint2 uu = *(const uint2*)(us + PHYS(ue_)); \
      uint2 gg = *(const uint2*)(grl + tau); \
      float y0 = bflo(gg.x) * (ACC[4 * g4 + 0] + dv * bflo(uu.x)); \
      float y1 = bfhi(gg.x) * (ACC[4 * g4 + 1] + dv * bfhi(uu.x)); \
      float y2 = bflo(gg.y) * (ACC[4 * g4 + 2] + dv * bflo(uu.y)); \
      float y3 = bfhi(gg.y) * (ACC[4 * g4 + 3] + dv * bfhi(uu.y)); \
      uint2 oo; oo.x = pack2(y0, y1); oo.y = pack2(y2, y3); \
      if (order == 0) *(uint2*)(us + PHYS(ue_)) = oo; else *(uint2*)(dst + tau) = oo; \
    } } while (0)
  HY_EPI(acc0, 0); HY_EPI(acc1, 1); HY_EPI(acc2, 2); HY_EPI(acc3, 3);
  }
}

__device__ __forceinline__ void hyena_phase(const Params& p, char* smem) {
  for (int b = blockIdx.x; b < 256; b += gridDim.x) {
#pragma unroll 1
    for (int u = 0; u < 2; ++u) hyena_unit<true>(p, b + 256 * u, smem);
#pragma unroll 1
    for (int u = 0; u < 2; ++u) hyena_unit<false>(p, b + 256 * u, smem);
  }
}
__global__ void __launch_bounds__(512) k_hyena(Params p, int order) {
  extern __shared__ __attribute__((aligned(16))) char smem[];
  hyena_phase(p, smem);
}

#define VSTR 144
#define ATT_WAVE_LDS (32 * VSTR)
#define ATT_OL_OFF (8 * ATT_WAVE_LDS)
#define OLSTR 136
#define ATT_ML_OFF (ATT_OL_OFF + 512 * OLSTR)
typedef short v4s __attribute__((ext_vector_type(4)));
typedef __attribute__((address_space(3))) v4s* lds_v4s_ptr;

struct AttnLane { int n, h, troff, vkey0, vpart; };

template <int QS>
__device__ __forceinline__ void attn_tiles(const u16* __restrict__ Kb, const u16* __restrict__ Vb, int seqbase, int L, int tmin, int tq,
                                           const AttnLane& al, char* vl, int dil, int ntile, float nslope,
                                           bf16x8 qf0, bf16x8 qf1, bf16x8 qf2, bf16x8 qf3,
                                           f32x16& o0, f32x16& o1, float& m_run, float& l_run) {
  const int n = al.n, h = al.h;
  const int kbase = tmin - 64 * dil;
  const float fd = (float)dil;
  const float dl0 = (float)(-64 * dil - QS * n + 4 * h * dil);
  const float lo = fmaxf(-64.f * fd, -(float)tq);
  const float hi = fminf(64.f * fd, (float)(L - 1 - tq));
  const float vmid = 0.5f * (lo + hi), vhalf = 0.5f * (hi - lo);
  int ja = 0, jb = ntile - 1;
  while (ja <= jb && (kbase + 32 * ja * dil + 31 * dil < 0)) ++ja;
  while (jb >= ja && (kbase + 32 * jb * dil >= L)) --jb;
  if (ja > jb) return;
#define ATT_LOADKV(SFX, J) do { \
    const int tk0_ = kbase + 32 * (J) * dil; \
    int tk_ = tk0_ + n * dil; tk_ = min(max(tk_, 0), L - 1); \
    const u16* krow_ = Kb + (long)(seqbase + tk_) * 512 + 8 * h; \
    k0##SFX = *(const bf16x8*)(krow_); k1##SFX = *(const bf16x8*)(krow_ + 16); k2##SFX = *(const bf16x8*)(krow_ + 32); k3##SFX = *(const bf16x8*)(krow_ + 48); \
    int tv_; \
    tv_ = tk0_ + (al.vkey0) * dil; tv_ = min(max(tv_, 0), L - 1); v0##SFX = *(const uint4*)(Vb + (long)(seqbase + tv_) * 512 + al.vpart * 8); \
    tv_ = tk0_ + (al.vkey0 + 8) * dil; tv_ = min(max(tv_, 0), L - 1); v1##SFX = *(const uint4*)(Vb + (long)(seqbase + tv_) * 512 + al.vpart * 8); \
    tv_ = tk0_ + (al.vkey0 + 16) * dil; tv_ = min(max(tv_, 0), L - 1); v2##SFX = *(const uint4*)(Vb + (long)(seqbase + tv_) * 512 + al.vpart * 8); \
    tv_ = tk0_ + (al.vkey0 + 24) * dil; tv_ = min(max(tv_, 0), L - 1); v3##SFX = *(const uint4*)(Vb + (long)(seqbase + tv_) * 512 + al.vpart * 8); } while (0)
#define ATT_STAGEV(SFX) do { \
    *(uint4*)(vl + (al.vkey0) * VSTR + al.vpart * 16) = v0##SFX; \
    *(uint4*)(vl + (al.vkey0 + 8) * VSTR + al.vpart * 16) = v1##SFX; \
    *(uint4*)(vl + (al.vkey0 + 16) * VSTR + al.vpart * 16) = v2##SFX; \
    *(uint4*)(vl + (al.vkey0 + 24) * VSTR + al.vpart * 16) = v3##SFX; } while (0)
  bf16x8 k0A, k1A, k2A, k3A, k0B, k1B, k2B, k3B;
  uint4 v0A, v1A, v2A, v3A, v0B, v1B, v2B, v3B;
  auto tile = [&](int j, bf16x8 kf0, bf16x8 kf1, bf16x8 kf2, bf16x8 kf3) {
    f32x16 S;
#pragma unroll
    for (int jj = 0; jj < 16; ++jj) S[jj] = 0.f;
    S = __builtin_amdgcn_mfma_f32_32x32x16_bf16(kf0, qf0, S, 0, 0, 0);
    S = __builtin_amdgcn_mfma_f32_32x32x16_bf16(kf1, qf1, S, 0, 0, 0);
    S = __builtin_amdgcn_mfma_f32_32x32x16_bf16(kf2, qf2, S, 0, 0, 0);
    S = __builtin_amdgcn_mfma_f32_32x32x16_bf16(kf3, qf3, S, 0, 0, 0);
    const float dt = dl0 + (float)(32 * j * dil);
    float mx = -1e30f;
#pragma unroll
    for (int jj = 0; jj < 16; ++jj) {
      float delta = dt + fd * (float)((jj & 3) + 8 * (jj >> 2));
      bool ok = fabsf(delta - vmid) <= vhalf;
      float sc = S[jj] + nslope * fabsf(delta);
      sc = ok ? sc : -1e30f;
      S[jj] = sc;
      mx = fmaxf(mx, sc);
    }
    mx = fmaxf(mx, __shfl_xor(mx, 32));
    const float m_new = fmaxf(m_run, mx);
    const float alpha = __builtin_amdgcn_exp2f(m_run - m_new);
    m_run = m_new;
    const float m_safe = fmaxf(m_new, -1e20f);
    float psum = 0.f;
    float pv[16];
#pragma unroll
    for (int jj = 0; jj < 16; ++jj) {
      float pe = __builtin_amdgcn_exp2f(S[jj] - m_safe);
      pv[jj] = pe; psum += pe;
    }
    l_run = l_run * alpha + psum;
#pragma unroll
    for (int jj = 0; jj < 16; ++jj) { o0[jj] *= alpha; o1[jj] *= alpha; }
    union { unsigned u[4]; bf16x8 v; } pf0, pf1;
#pragma unroll
    for (int q = 0; q < 4; ++q) { pf0.u[q] = pg8::cvt_pk_bf16(pv[2 * q], pv[2 * q + 1]); pf1.u[q] = pg8::cvt_pk_bf16(pv[8 + 2 * q], pv[8 + 2 * q + 1]); }
    __builtin_amdgcn_wave_barrier();
#define TRRD(s2, hh, dtt) __builtin_amdgcn_ds_read_tr16_b64_v4i16((lds_v4s_ptr)(vl + al.troff + (16 * (s2) + 8 * (hh)) * VSTR + 64 * (dtt)))
    {
      v4s a00 = TRRD(0, 0, 0), a01 = TRRD(0, 1, 0), b00 = TRRD(0, 0, 1), b01 = TRRD(0, 1, 1);
      v4s a10 = TRRD(1, 0, 0), a11 = TRRD(1, 1, 0), b10 = TRRD(1, 0, 1), b11 = TRRD(1, 1, 1);
      bf16x8 va0 = __builtin_shufflevector(a00, a01, 0, 1, 2, 3, 4, 5, 6, 7);
      bf16x8 vb0 = __builtin_shufflevector(b00, b01, 0, 1, 2, 3, 4, 5, 6, 7);
      bf16x8 va1 = __builtin_shufflevector(a10, a11, 0, 1, 2, 3, 4, 5, 6, 7);
      bf16x8 vb1 = __builtin_shufflevector(b10, b11, 0, 1, 2, 3, 4, 5, 6, 7);
      o0 = __builtin_amdgcn_mfma_f32_32x32x16_bf16(va0, pf0.v, o0, 0, 0, 0);
      o1 = __builtin_amdgcn_mfma_f32_32x32x16_bf16(vb0, pf0.v, o1, 0, 0, 0);
      o0 = __builtin_amdgcn_mfma_f32_32x32x16_bf16(va1, pf1.v, o0, 0, 0, 0);
      o1 = __builtin_amdgcn_mfma_f32_32x32x16_bf16(vb1, pf1.v, o1, 0, 0, 0);
    }
    __builtin_amdgcn_wave_barrier();
  };
  ATT_LOADKV(A, ja);
  if (ja + 1 <= jb) ATT_LOADKV(B, ja + 1);
#pragma unroll 1
  for (int j = ja; j <= jb; j += 2) {
    {
      const bf16x8 kf0 = k0A, kf1 = k1A, kf2 = k2A, kf3 = k3A;
      ATT_STAGEV(A);
      if (j + 2 <= jb) ATT_LOADKV(A, j + 2);
      tile(j, kf0, kf1, kf2, kf3);
    }
    if (j + 1 > jb) break;
    {
      const bf16x8 kf0 = k0B, kf1 = k1B, kf2 = k2B, kf3 = k3B;
      ATT_STAGEV(B);
      if (j + 3 <= jb) ATT_LOADKV(B, j + 3);
      tile(j + 1, kf0, kf1, kf2, kf3);
    }
  }
}

__device__ __forceinline__ void attn_unit(const Params& p, int unit, char* smem, int lane_in, int w, u16* obase) {
  int lane = lane_in; asm volatile("" : "+v"(lane));
  int seqbase, L, head, blk;
  if (unit < 512) { int sq = unit >> 6, rem = unit & 63; seqbase = sq * 4096; L = 4096; head = rem >> 3; blk = rem & 7; }
  else { int u2 = unit - 512; int sq = u2 >> 8, rem = u2 & 255; seqbase = 32768 + sq * 16384; L = 16384; head = rem >> 5; blk = rem & 31; }
  const int tb = blk * 512;
  AttnLane al;
  al.n = lane & 31; al.h = lane >> 5;
  { const int g = lane >> 4, i16 = lane & 15, tq4 = i16 >> 2, tp4 = i16 & 3;
    al.troff = (4 * (g >> 1) + tq4) * VSTR + (16 * (g & 1) + 4 * tp4) * 2; }
  al.vkey0 = lane >> 3; al.vpart = lane & 7;
  const int n = al.n, h = al.h;
  const u16* Qb = (const u16*)(p.ws + OFF_QB);
  const u16* Kb = (const u16*)(p.ws + OFF_KB) + head * 64;
  const u16* Vb = (const u16*)(p.ws + OFF_VB) + head * 64;
  char* vl = smem + w * ATT_WAVE_LDS;
  char* OL = smem + ATT_OL_OFF;
  float2* ML = (float2*)(smem + ATT_ML_OFF);
  const float nslope = -exp2f(-(float)(head + 1)) * LOG2E;
  bf16x8 qn0, qn1, qn2, qn3;
#define ATT_QLOAD(G) do { const int g_ = (G); if (g_ < 6) { \
    const int gg_ = 2 * w + (g_ & 1), ps_ = g_ >> 1; \
    const int tq_ = (ps_ == 0) ? (tb + 32 * gg_ + n) : ((ps_ == 1) ? (tb + (gg_ >> 2) * 128 + (gg_ & 3) + 4 * n) : (tb + gg_ + 16 * n)); \
    const u16* qr_ = Qb + (long)(seqbase + tq_) * 512 + head * 64; \
    qn0 = *(const bf16x8*)(qr_ + 8 * h); qn1 = *(const bf16x8*)(qr_ + 16 + 8 * h); \
    qn2 = *(const bf16x8*)(qr_ + 32 + 8 * h); qn3 = *(const bf16x8*)(qr_ + 48 + 8 * h); } } while (0)
  ATT_QLOAD(0);
  __syncthreads();
#pragma unroll 1
  for (int gi = 0; gi < 2; ++gi) {
    const int tl0 = 32 * (2 * w + gi);
    const int tmin = tb + tl0, tq = tmin + n;
    const bf16x8 qf0 = qn0, qf1 = qn1, qf2 = qn2, qf3 = qn3;
    ATT_QLOAD(0 + gi + 1);
    f32x16 o0, o1;
#pragma unroll
    for (int j = 0; j < 16; ++j) { o0[j] = 0.f; o1[j] = 0.f; }
    float m_run = -1e30f, l_run = 0.f;
    attn_tiles<1>(Kb, Vb, seqbase, L, tmin, tq, al, vl, 1, 5, nslope, qf0, qf1, qf2, qf3, o0, o1, m_run, l_run);
    const float ltot = l_run + __shfl_xor(l_run, 32);
    const float inv = 1.f / ltot;
    char* orow = OL + (tl0 + n) * OLSTR;
#pragma unroll
    for (int g4 = 0; g4 < 4; ++g4) {
      uint2 w0, w1;
      w0.x = pack2(o0[4 * g4] * inv, o0[4 * g4 + 1] * inv); w0.y = pack2(o0[4 * g4 + 2] * inv, o0[4 * g4 + 3] * inv);
      w1.x = pack2(o1[4 * g4] * inv, o1[4 * g4 + 1] * inv); w1.y = pack2(o1[4 * g4 + 2] * inv, o1[4 * g4 + 3] * inv);
      *(uint2*)(orow + (8 * g4 + 4 * h) * 2) = w0;
      *(uint2*)(orow + (32 + 8 * g4 + 4 * h) * 2) = w1;
    }
    if (h == 0) ML[tl0 + n] = make_float2(m_run, ltot);
  }
  __syncthreads();
#pragma unroll 1
  for (int gi = 0; gi < 2; ++gi) {
    const int g = 2 * w + gi;
    const int tl0 = (g >> 2) * 128 + (g & 3);
    const int tmin = tb + tl0, tq = tmin + 4 * n;
    const int tl = tl0 + 4 * n;
    const bf16x8 qf0 = qn0, qf1 = qn1, qf2 = qn2, qf3 = qn3;
    ATT_QLOAD(2 + gi + 1);
    const float2 ml = ML[tl];
    float m_run = ml.x, l_run = (h == 0) ? ml.y : 0.f;
    f32x16 o0, o1;
    char* orow = OL + tl * OLSTR;
#pragma unroll
    for (int g4 = 0; g4 < 4; ++g4) {
      uint2 w0 = *(const uint2*)(orow + (8 * g4 + 4 * h) * 2), w1 = *(const uint2*)(orow + (32 + 8 * g4 + 4 * h) * 2);
      o0[4 * g4] = bflo(w0.x) * ml.y; o0[4 * g4 + 1] = bfhi(w0.x) * ml.y; o0[4 * g4 + 2] = bflo(w0.y) * ml.y; o0[4 * g4 + 3] = bfhi(w0.y) * ml.y;
      o1[4 * g4] = bflo(w1.x) * ml.y; o1[4 * g4 + 1] = bfhi(w1.x) * ml.y; o1[4 * g4 + 2] = bflo(w1.y) * ml.y; o1[4 * g4 + 3] = bfhi(w1.y) * ml.y;
    }
    attn_tiles<4>(Kb, Vb, seqbase, L, tmin, tq, al, vl, 4, 5, nslope, qf0, qf1, qf2, qf3, o0, o1, m_run, l_run);
    const float ltot = l_run + __shfl_xor(l_run, 32);
    const float inv = 1.f / ltot;
#pragma unroll
    for (int g4 = 0; g4 < 4; ++g4) {
      uint2 w0, w1;
      w0.x = pack2(o0[4 * g4] * inv, o0[4 * g4 + 1] * inv); w0.y = pack2(o0[4 * g4 + 2] * inv, o0[4 * g4 + 3] * inv);
      w1.x = pack2(o1[4 * g4] * inv, o1[4 * g4 + 1] * inv); w1.y = pack2(o1[4 * g4 + 2] * inv, o1[4 * g4 + 3] * inv);
      *(uint2*)(orow + (8 * g4 + 4 * h) * 2) = w0;
      *(uint2*)(orow + (32 + 8 * g4 + 4 * h) * 2) = w1;
    }
    if (h == 0) ML[tl] = make_float2(m_run, ltot);
  }
  __syncthreads();
#pragma unroll 1
  for (int ri = 0; ri < 2; ++ri) {
    const int r = 2 * w + ri;
    const int tmin = tb + r, tq = tmin + 16 * n;
    const int tl = r + 16 * n;
    const bf16x8 qf0 = qn0, qf1 = qn1, qf2 = qn2, qf3 = qn3;
    ATT_QLOAD(4 + ri + 1);
    const float2 ml = ML[tl];
    float m_run = ml.x, l_run = (h == 0) ? ml.y : 0.f;
    f32x16 o0, o1;
    const char* orow = OL + tl * OLSTR;
#pragma unroll
    for (int g4 = 0; g4 < 4; ++g4) {
      uint2 w0 = *(const uint2*)(orow + (8 * g4 + 4 * h) * 2), w1 = *(const uint2*)(orow + (32 + 8 * g4 + 4 * h) * 2);
      o0[4 * g4] = bflo(w0.x) * ml.y; o0[4 * g4 + 1] = bfhi(w0.x) * ml.y; o0[4 * g4 + 2] = bflo(w0.y) * ml.y; o0[4 * g4 + 3] = bfhi(w0.y) * ml.y;
      o1[4 * g4] = bflo(w1.x) * ml.y; o1[4 * g4 + 1] = bfhi(w1.x) * ml.y; o1[4 * g4 + 2] = bflo(w1.y) * ml.y; o1[4 * g4 + 3] = bfhi(w1.y) * ml.y;
    }
    attn_tiles<16>(Kb, Vb, seqbase, L, tmin, tq, al, vl, 16, 5, nslope, qf0, qf1, qf2, qf3, o0, o1, m_run, l_run);
    const float ltot = l_run + __shfl_xor(l_run, 32);
    const float inv = 1.f / ltot;
    u16* orow_g = obase + (long)(seqbase + tq) * 512 + head * 64;
#pragma unroll
    for (int g4 = 0; g4 < 4; ++g4) {
      uint2 w0, w1;
      w0.x = pack2(o0[4 * g4] * inv, o0[4 * g4 + 1] * inv); w0.y = pack2(o0[4 * g4 + 2] * inv, o0[4 * g4 + 3] * inv);
      w1.x = pack2(o1[4 * g4] * inv, o1[4 * g4 + 1] * inv); w1.y = pack2(o1[4 * g4 + 2] * inv, o1[4 * g4 + 3] * inv);
      *(uint2*)(orow_g + 8 * g4 + 4 * h) = w0;
      *(uint2*)(orow_g + 32 + 8 * g4 + 4 * h) = w1;
    }
  }
}

__device__ __forceinline__ void attn_phase(const Params& p, char* smem, u16* obase) {
  const int lane = threadIdx.x & 63;
  const int w = __builtin_amdgcn_readfirstlane(threadIdx.x >> 6);
  if (gridDim.x == 256) {
    const int x = blockIdx.x & 7, c = blockIdx.x >> 3;
#pragma unroll 1
    for (int k = 0; k < 4; ++k) attn_unit(p, x * 128 + k * 32 + c, smem, lane, w, obase);
  } else {
    const int per = (1024 + gridDim.x - 1) / gridDim.x;
#pragma unroll 1
    for (int k = 0; k < per; ++k) {
      int unit = blockIdx.x * per + k;
      if (unit < 1024) attn_unit(p, unit, smem, lane, w, obase);
    }
  }
}
#define ATTN_PHASE(p, smem) attn_phase(p, smem, (u16*)(p.ws + OFF_QB))

#define MEGA_LDS HY_LDS
#ifndef PROBE_DOUBLE
#define PROBE_DOUBLE 0
#endif
#ifndef ATTN_PHASE
#define ATTN_PHASE(p, smem) attn_naive_phase(p)
#endif

__global__ void __launch_bounds__(512) mega(Params p) {
  extern __shared__ __attribute__((aligned(16))) char smem[];
  cg::grid_group grid = cg::this_grid();
  phase0(p, smem);
  convert_wout(p);
  grid.sync();
  phase1_v8(p, smem);
  grid.sync();
  ATTN_PHASE(p, smem);
  hyena_phase(p, smem);
  grid.sync();
  phase4_v8(p, smem);
}

static Params make_params(void* const* d_in, void* d_out, void* d_ws) {
  Params p{};
  p.x0 = (const float*)d_in[0]; p.x1 = (const float*)d_in[1]; p.w_in = (const float*)d_in[2];
  p.conv_w = (const float*)d_in[3]; p.conv_b = (const float*)d_in[4];
  p.fw1 = (const float*)d_in[5]; p.fb1 = (const float*)d_in[6]; p.fw2 = (const float*)d_in[7]; p.fb2 = (const float*)d_in[8];
  p.fw3 = (const float*)d_in[9]; p.fb3 = (const float*)d_in[10]; p.ffreq = (const float*)d_in[11]; p.fw4 = (const float*)d_in[12];
  p.hyd = (const float*)d_in[13]; p.gna = (const float*)d_in[14]; p.gnh = (const float*)d_in[15];
  p.w_out = (const float*)d_in[16]; p.lng = (const float*)d_in[17]; p.lnb = (const float*)d_in[18];
  p.out = (float*)d_out; p.ws = (char*)d_ws;
  return p;
}

extern "C" void kernel_launch(void* const* d_in, const int* in_sizes, int n_in,
                              void* d_out, int out_size, void* d_ws, size_t ws_size,
                              hipStream_t stream) {
  Params p = make_params(d_in, d_out, d_ws);
  static int grid_blocks = 0;
  if (!grid_blocks) {
    (void)hipFuncSetAttribute((const void*)mega, hipFuncAttributeMaxDynamicSharedMemorySize, MEGA_LDS);
    int dev = 0, cus = 0, per_cu = 0;
    (void)hipGetDevice(&dev);
    (void)hipDeviceGetAttribute(&cus, hipDeviceAttributeMultiprocessorCount, dev);
    (void)hipOccupancyMaxActiveBlocksPerMultiprocessor(&per_cu, mega, 512, MEGA_LDS);
    if (per_cu < 1) per_cu = 1;
    grid_blocks = cus;
    if (grid_blocks > 256) grid_blocks = 256;
  }
  void* args[] = {&p};
  hipError_t e = hipLaunchCooperativeKernel((void*)mega, dim3(grid_blocks), dim3(512), args, MEGA_LDS, stream);
  if (e != hipSuccess) fprintf(stderr, "cooperative launch failed: %s (grid %d)\n", hipGetErrorString(e), grid_blocks);
}
```
